# Optimizing an MI355X kernel written in HIP

```python
import math
import jax, jax.numpy as jnp
from jax import lax
import numpy as np

D_MODEL = 1024
BATCH = 4
SEQ = 8192
DEPTH = 2

GRID_W = 64
CTX_LEN = 256
N_MIXERS = 2
N_HEADS = 16
HEAD_DIM = D_MODEL // N_HEADS
NA_KH = 8
NA_KW = 16
SWA_KV_HEADS = 4
SWA_GROUP = N_HEADS // SWA_KV_HEADS
SWA_WINDOW = 128
SWA_BLOCK = 128
D_FF = 4 * D_MODEL
ROPE_BASE = 10000.0
NORM_EPS = 1e-6
NEG_INF = -1e30
N_NA_LAYERS = (DEPTH + 1) // 2
N_SWA_LAYERS = DEPTH // 2

kernel_name = "hybrid_natten_swa_prefix_dit"


def rms_norm(x, g):
    xf = x.astype(jnp.float32)
    y = xf * lax.rsqrt(jnp.mean(xf * xf, axis=-1, keepdims=True) + NORM_EPS)
    return (y * g.astype(jnp.float32)).astype(x.dtype)


def modulate(h, shift, scale):
    return h * (1 + scale) + shift


def squared_relu_mlp(h, w1, w2):
    return jnp.square(jax.nn.relu(h @ w1)) @ w2


def axial_rope_tables(L):
    t = jnp.arange(L, dtype=jnp.int32)
    row = (t // GRID_W).astype(jnp.float32)
    col = (t % GRID_W).astype(jnp.float32)
    n_freq = HEAD_DIM // 4
    inv = ROPE_BASE ** (-jnp.arange(n_freq, dtype=jnp.float32) / n_freq)
    ang = jnp.stack([row[:, None] * inv, col[:, None] * inv], axis=1)
    return jnp.cos(ang), jnp.sin(ang)


def apply_axial_rope(x, cos, sin):
    B, L, h, dh = x.shape
    xr = x.astype(jnp.float32).reshape(B, L, h, 2, 2, dh // 4)
    x1, x2 = xr[..., 0, :], xr[..., 1, :]
    cb = cos[None, :, None]
    sb = sin[None, :, None]
    out = jnp.stack([x1 * cb - x2 * sb, x1 * sb + x2 * cb], axis=-2)
    return out.reshape(B, L, h, dh).astype(x.dtype)


def context_attention(q, k, v, sink=None):
    B, C, KV, G, dh = q.shape
    s = jnp.einsum('bqkgd,bskd->bkgqs', q, k, preferred_element_type=jnp.float32) * (dh ** -0.5)
    if sink is not None:
        s_sink = jnp.broadcast_to(sink.reshape(1, KV, G, 1, 1).astype(jnp.float32), (B, KV, G, C, 1))
        s = jnp.concatenate([s, s_sink], axis=-1)
    p = jax.nn.softmax(s, axis=-1)[..., :C].astype(v.dtype)
    o = jnp.einsum('bkgqs,bskd->bqkgd', p, v)
    return o.reshape(B, C, KV * G * dh)


def neighborhood_attention(q, k, v, kc, vc, rpb):
    B, L, H, dh = q.shape
    rows = L // GRID_W
    kh = min(NA_KH, rows)
    kw = min(NA_KW, GRID_W)
    n_loc = kh * kw
    scale = dh ** -0.5
    qg = q.reshape(B, rows, GRID_W, H, dh)
    kg = k.reshape(B, rows, GRID_W, H, dh)
    vg = v.reshape(B, rows, GRID_W, H, dh)
    cols = jnp.arange(GRID_W)
    col_start = jnp.clip(cols - kw // 2, 0, GRID_W - kw)
    col_idx = col_start[:, None] + jnp.arange(kw)[None, :]
    col_off = col_idx - cols[:, None] + (NA_KW - 1)

    def one_row(r):
        r0 = jnp.clip(r - kh // 2, 0, rows - kh)
        k_rows = lax.dynamic_slice_in_dim(kg, r0, kh, axis=1)
        v_rows = lax.dynamic_slice_in_dim(vg, r0, kh, axis=1)
        k_win = k_rows[:, :, col_idx]
        v_win = v_rows[:, :, col_idx]
        q_row = lax.dynamic_index_in_dim(qg, r, axis=1, keepdims=False)
        s_loc = jnp.einsum('bqhd,bkqwhd->bhqkw', q_row, k_win,
                           preferred_element_type=jnp.float32) * scale
        row_off = r0 + jnp.arange(kh) - r + (NA_KH - 1)
        bias = rpb[:, row_off[:, None, None], col_off[None, :, :]]
        s_loc = s_loc + jnp.transpose(bias, (0, 2, 1, 3)).astype(jnp.float32)[None]
        s_ctx = jnp.einsum('bqhd,bchd->bhqc', q_row, kc,
                           preferred_element_type=jnp.float32) * scale
        s = jnp.concatenate([s_loc.reshape(B, H, GRID_W, n_loc), s_ctx], axis=-1)
        p = jax.nn.softmax(s, axis=-1).astype(v.dtype)
        p_loc = p[..., :n_loc].reshape(B, H, GRID_W, kh, kw)
        p_ctx = p[..., n_loc:]
        return (jnp.einsum('bhqkw,bkqwhd->bqhd', p_loc, v_win)
                + jnp.einsum('bhqc,bchd->bqhd', p_ctx, vc))

    out = lax.map(one_row, jnp.arange(rows))
    return jnp.transpose(out, (1, 0, 2, 3, 4)).reshape(B, L, H * dh)


def sliding_window_attention(q, k, v, kc, vc, sink):
    B, L, KV, G, dh = q.shape
    C = kc.shape[1]
    T = SWA_BLOCK
    nb = L // T
    scale = dh ** -0.5
    qb = q.reshape(B, nb, T, KV, G, dh)
    pad = jnp.zeros((B, T, KV, dh), k.dtype)
    kp = jnp.concatenate([pad, k, pad], axis=1)
    vp = jnp.concatenate([pad, v, pad], axis=1)
    rel = (jnp.arange(3 * T)[None, :] - T) - jnp.arange(T)[:, None]
    s_sink = jnp.broadcast_to(sink.reshape(1, KV, G, 1, 1).astype(jnp.float32), (B, KV, G, T, 1))

    def one_block(j):
        q_blk = lax.dynamic_index_in_dim(qb, j, axis=1, keepdims=False)
        k_blk = lax.dynamic_slice_in_dim(kp, j * T, 3 * T, axis=1)
        v_blk = lax.dynamic_slice_in_dim(vp, j * T, 3 * T, axis=1)
        kpos = (j - 1) * T + jnp.arange(3 * T)
        valid = (jnp.abs(rel) <= SWA_WINDOW) & ((kpos >= 0) & (kpos < L))[None, :]
        s_loc = jnp.einsum('bqkgd,bskd->bkgqs', q_blk, k_blk,
                           preferred_element_type=jnp.float32) * scale
        s_loc = jnp.where(valid, s_loc, NEG_INF)
        s_ctx = jnp.einsum('bqkgd,bckd->bkgqc', q_blk, kc,
                           preferred_element_type=jnp.float32) * scale
        s = jnp.concatenate([s_loc, s_ctx, s_sink], axis=-1)
        p = jax.nn.softmax(s, axis=-1).astype(v.dtype)
        return (jnp.einsum('bkgqs,bskd->bqkgd', p[..., :3 * T], v_blk)
                + jnp.einsum('bkgqc,bckd->bqkgd', p[..., 3 * T:3 * T + C], vc))

    out = lax.map(one_block, jnp.arange(nb))
    return jnp.transpose(out, (1, 0, 2, 3, 4, 5)).reshape(B, L, KV * G * dh)


def setup_inputs(seed: int = 0) -> dict:
    key = jax.random.key(seed)
    ks = jax.random.split(key, 24)
    f = jnp.float32
    d = D_MODEL
    kv_w = SWA_KV_HEADS * HEAD_DIM

    def nrm(k, shape, scale):
        return jax.random.normal(k, shape, f) * scale

    return {
        "x": nrm(ks[0], (BATCH, SEQ, d), 1.0),
        "c": nrm(ks[1], (BATCH, d), 1.0),
        "ctx": nrm(ks[2], (BATCH, CTX_LEN, d), 1.0),
        "c_ctx": nrm(ks[3], (d,), 1.0),
        "ada_w": nrm(ks[4], (DEPTH, d, 6 * d), 0.5 * d ** -0.5),
        "ada_b": nrm(ks[5], (DEPTH, 6 * d), 0.02),
        "g_mix": 1.0 + nrm(ks[6], (DEPTH, d), 0.02),
        "g_mlp": 1.0 + nrm(ks[7], (DEPTH, d), 0.02),
        "mlp_w1": nrm(ks[8], (DEPTH, d, D_FF), d ** -0.5),
        "mlp_w2": nrm(ks[9], (DEPTH, D_FF, d), D_FF ** -0.5),
        "na_wqkv": nrm(ks[10], (N_NA_LAYERS, d, 3 * d), d ** -0.5),
        "na_q_gain": 1.0 + nrm(ks[11], (N_NA_LAYERS, HEAD_DIM), 0.02),
        "na_k_gain": 1.0 + nrm(ks[12], (N_NA_LAYERS, HEAD_DIM), 0.02),
        "na_rpb": nrm(ks[13], (N_NA_LAYERS, N_HEADS, 2 * NA_KH - 1, 2 * NA_KW - 1), 0.1),
        "na_wo": nrm(ks[14], (N_NA_LAYERS, d, d), d ** -0.5),
        "swa_wqkv": nrm(ks[15], (N_SWA_LAYERS, d, d + 2 * kv_w), d ** -0.5),
        "swa_q_gain": 1.0 + nrm(ks[16], (N_SWA_LAYERS, HEAD_DIM), 0.02),
        "swa_k_gain": 1.0 + nrm(ks[17], (N_SWA_LAYERS, HEAD_DIM), 0.02),
        "swa_sink": nrm(ks[18], (N_SWA_LAYERS, N_HEADS), 0.5),
        "swa_wo": nrm(ks[19], (N_SWA_LAYERS, d, d), d ** -0.5),
    }


def reference(x, c, ctx, c_ctx, ada_w, ada_b, g_mix, g_mlp, mlp_w1, mlp_w2,
              na_wqkv, na_q_gain, na_k_gain, na_rpb, na_wo,
              swa_wqkv, swa_q_gain, swa_k_gain, swa_sink, swa_wo):
    B, L, D = x.shape
    C = ctx.shape[1]
    H, dh, KV, G = N_HEADS, HEAD_DIM, SWA_KV_HEADS, SWA_GROUP
    cos, sin = axial_rope_tables(L)
    silu_c = jax.nn.silu(c)
    silu_cc = jax.nn.silu(c_ctx)
    h_lat = x
    h_ctx = ctx
    for i in range(DEPTH):
        last = i == DEPTH - 1
        j = i // N_MIXERS
        mod_lat = (silu_c @ ada_w[i] + ada_b[i])[:, None, :]
        mod_ctx = (silu_cc @ ada_w[i] + ada_b[i])[None, None, :]
        sh1, sc1, ga1, sh2, sc2, ga2 = jnp.split(mod_lat, 6, axis=-1)
        csh1, csc1, cga1, csh2, csc2, cga2 = jnp.split(mod_ctx, 6, axis=-1)
        u_lat = modulate(rms_norm(h_lat, g_mix[i]), sh1, sc1)
        u_ctx = modulate(rms_norm(h_ctx, g_mix[i]), csh1, csc1)

        if i % N_MIXERS == 0:
            w = na_wqkv[j]
            ql, kl, vl = jnp.split((u_lat @ w).reshape(B, L, 3, H, dh), 3, axis=2)
            qc, kc, vc = jnp.split((u_ctx @ w).reshape(B, C, 3, H, dh), 3, axis=2)
            ql, kl, vl = ql[:, :, 0], kl[:, :, 0], vl[:, :, 0]
            qc, kc, vc = qc[:, :, 0], kc[:, :, 0], vc[:, :, 0]
            ql, qc = rms_norm(ql, na_q_gain[j]), rms_norm(qc, na_q_gain[j])
            kl, kc = rms_norm(kl, na_k_gain[j]), rms_norm(kc, na_k_gain[j])
            y_lat = neighborhood_attention(ql, kl, vl, kc, vc, na_rpb[j]) @ na_wo[j]
            if not last:
                y_ctx = context_attention(qc[:, :, :, None, :], kc, vc) @ na_wo[j]
        else:
            w = swa_wqkv[j]
            pl = u_lat @ w
            pc = u_ctx @ w
            kvw = KV * dh
            ql = pl[..., :D].reshape(B, L, H, dh)
            kl = pl[..., D:D + kvw].reshape(B, L, KV, dh)
            vl = pl[..., D + kvw:].reshape(B, L, KV, dh)
            qc = pc[..., :D].reshape(B, C, H, dh)
            kc = pc[..., D:D + kvw].reshape(B, C, KV, dh)
            vc = pc[..., D + kvw:].reshape(B, C, KV, dh)
            ql, qc = rms_norm(ql, swa_q_gain[j]), rms_norm(qc, swa_q_gain[j])
            kl, kc = rms_norm(kl, swa_k_gain[j]), rms_norm(kc, swa_k_gain[j])
            ql = apply_axial_rope(ql, cos, sin)
            kl = apply_axial_rope(kl, cos, sin)
            y_lat = sliding_window_attention(ql.reshape(B, L, KV, G, dh), kl, vl,
                                             kc, vc, swa_sink[j]) @ swa_wo[j]
            if not last:
                y_ctx = context_attention(qc.reshape(B, C, KV, G, dh), kc, vc,
                                          sink=swa_sink[j]) @ swa_wo[j]

        h_lat = h_lat + ga1 * y_lat
        h_lat = h_lat + ga2 * squared_relu_mlp(
            modulate(rms_norm(h_lat, g_mlp[i]), sh2, sc2), mlp_w1[i], mlp_w2[i])
        if not last:
            h_ctx = h_ctx + cga1 * y_ctx
            h_ctx = h_ctx + cga2 * squared_relu_mlp(
                modulate(rms_norm(h_ctx, g_mlp[i]), csh2, csc2), mlp_w1[i], mlp_w2[i])
    return h_lat
```

```cpp
#include <hip/hip_runtime.h>
#include <hip/hip_cooperative_groups.h>
#include <cstdio>
#include <cstdint>
namespace cg = cooperative_groups;
namespace pg8 {
#define PG8_LAS __attribute__((address_space(3)))
typedef unsigned short bf16_t;
typedef short bf16x8 __attribute__((ext_vector_type(8)));
typedef float f32x4 __attribute__((ext_vector_type(4)));
typedef unsigned u32x4 __attribute__((ext_vector_type(4)));
constexpr int BM = 256, BK = 64, HALF = 128, HTB = HALF * BK * 2  , STAGE_BYTES = 8 * HTB, NXCD = 8, WGM = 8;

__host__ __device__ __forceinline__ int lds_byte(int r, int c) { const int st = (r >> 4) * 2 + (c >> 5), rr = r & 15, cc = c & 31, ob = rr * 64 + cc * 2; return st * 1024 + (ob ^ (((ob >> 9) & 1) << 5)); }
__host__ __device__ __forceinline__ void stage_rc(int b, int& R, int& C) { const int st = b / 1024, sb = b % 1024, swz = sb ^ (((sb >> 9) & 1) << 5); R = (st >> 1) * 16 + swz / 64; C = (st & 1) * 32 + (swz % 64) / 2; }
__host__ __device__ __forceinline__ int perm32(int rho) { const int n = rho >> 4, i = rho & 15; return 8 * (i >> 2) + 4 * n + (i & 3); }

struct Unit { int pm, pn, k0, nt; };
struct Gemm { const bf16_t* A; const bf16_t* Bt; int M, N, K; };

struct StaticOrder {
    int nM, nN, nwg, G, c;
    __host__ __device__ void init(int M, int N, int G_, int c_) { nM = M / BM; nN = N / BM; nwg = nM * nN; G = G_; c = c_; }
    __host__ __device__ bool next(int i, Unit& u) const {
        const long L = (long)i * G + c; if (L >= nwg) return false;
        int wgid = (int)L; { const int q = nwg / NXCD, r = nwg % NXCD, xcd = wgid % NXCD, off = wgid / NXCD; wgid = (xcd < r ? xcd * (q + 1) : r * (q + 1) + (xcd - r) * q) + off; }
        const int nig = WGM * nN, gid = wgid / nig, fm = gid * WGM, gsz = (nM - fm) < WGM ? (nM - fm) : WGM;
        u.pm = fm + ((wgid % nig) % gsz); u.pn = (wgid % nig) / gsz; u.k0 = 0; u.nt = 0; return true;
    }
    __device__ __forceinline__ void a_ready(const Unit&) const {}
    __device__ __forceinline__ void done(const Unit&) const {}
};

__device__ __forceinline__ unsigned cvt_pk_bf16(float lo, float hi) { unsigned r; asm volatile("v_cvt_pk_bf16_f32 %0, %1, %2" : "=v"(r) : "v"(lo), "v"(hi)); return r; }
template <class Epi, class Sched, bool ALIGN_EPI = false, bool SP2 = false>
__device__ __forceinline__ void gemm_phase(PG8_LAS unsigned char* lds, const Gemm g, const Sched& S, const Epi& E) {
    int tid_ = threadIdx.x; asm volatile("" : "+v"(tid_));
    const int tid = tid_, wid = __builtin_amdgcn_readfirstlane(tid >> 6), lane = tid & 63, wr = wid >> 2, wc = wid & 3, fr = lane & 15, fq = lane >> 4;
    const int K = g.K, ntf = K / BK;
    unsigned voffA[2], voffB[2];
#pragma unroll
    for (int i = 0; i < 2; ++i) { int R, C; stage_rc(tid * 16 + i * 8192, R, C); const int Rb = Epi::PERM ? ((R & ~31) + perm32(R & 31)) : R;
        voffA[i] = (unsigned)(R * K + C) * 2u; voffB[i] = (unsigned)(Rb * K + C) * 2u; }
    const size_t kstep = (size_t)(BK * 2);
    const size_t hstep = (size_t)HALF * K * 2;
    const size_t tstep = 2 * hstep;
    const unsigned ldsw = (unsigned)wid * 1024u;
    const int aoff = lds_byte(wr * 64 + fr, fq * 8), boff = lds_byte(wc * 32 + fr, fq * 8);
#define PG8_SA(b, h) (((b) * 2 + (h)) * HTB)
#define PG8_SB(b, h) ((4 + (b) * 2 + (h)) * HTB)
#define PG8_STAGE(bufoff, gbase, voff) do { _Pragma("unroll") for (int _i = 0; _i < 2; ++_i) \
        __builtin_amdgcn_global_load_lds((const unsigned*)((const char*)(gbase) + (voff)[_i]), (PG8_LAS unsigned*)(lds + (bufoff) + ldsw + _i * 8192), 16, 0, 0); } while (0)
#define PG8_LDA(dst, b, h) do { _Pragma("unroll") for (int m = 0; m < 4; ++m) _Pragma("unroll") for (int k = 0; k < 2; ++k) dst[m][k] = *(const PG8_LAS bf16x8*)(lds + PG8_SA(b, h) + aoff + m * 2048 + k * 1024); } while (0)
#define PG8_LDB(dst, b, h) do { _Pragma("unroll") for (int n = 0; n < 2; ++n) _Pragma("unroll") for (int k = 0; k < 2; ++k) dst[n][k] = *(const PG8_LAS bf16x8*)(lds + PG8_SB(b, h) + boff + n * 2048 + k * 1024); } while (0)
#define PG8_MMA(ai, bj, At, Bt) do { __builtin_amdgcn_s_setprio(1); _Pragma("unroll") for (int m = 0; m < 4; ++m) _Pragma("unroll") for (int n = 0; n < 2; ++n) _Pragma("unroll") for (int k = 0; k < 2; ++k) \
        acc[ai][bj][m][n] = __builtin_amdgcn_mfma_f32_16x16x32_bf16(Bt[n][k], At[m][k], acc[ai][bj][m][n], 0, 0, 0); __builtin_amdgcn_s_setprio(0); } while (0)
#define PG8_WAIT_V(n) asm volatile("s_waitcnt vmcnt(" #n ")" ::: "memory")
#define PG8_WAIT_L(n) asm volatile("s_waitcnt lgkmcnt(" #n ")" ::: "memory")
#define PG8_BAR __builtin_amdgcn_s_barrier()
#define PG8_SCHED __builtin_amdgcn_sched_barrier(0)
    Unit cur, nxt; int ui = 0;
    if (!S.next(0, cur)) return;
    f32x4 acc[2][2][4][2];
#pragma unroll
    for (int a = 0; a < 2; ++a)
#pragma unroll
        for (int b = 0; b < 2; ++b)
#pragma unroll
            for (int m = 0; m < 4; ++m)
#pragma unroll
                for (int n = 0; n < 2; ++n) acc[a][b][m][n] = (f32x4){0.f, 0.f, 0.f, 0.f};
    bf16x8 At[4][2], B0[2][2], B1[2][2];
    const char* cA = (const char*)g.A + (size_t)cur.pm * tstep + (size_t)cur.k0 * 2; const char* cB = (const char*)g.Bt + (size_t)cur.pn * tstep + (size_t)cur.k0 * 2;
    S.a_ready(cur);
    if constexpr (SP2) {
        PG8_STAGE(PG8_SB(0, 0), cB, voffB); PG8_STAGE(PG8_SB(0, 1), cB + hstep, voffB); PG8_STAGE(PG8_SA(0, 0), cA, voffA); PG8_STAGE(PG8_SA(0, 1), cA + hstep, voffA);
        if (wr == 1) PG8_BAR;
        PG8_WAIT_V(2); PG8_BAR;
        PG8_STAGE(PG8_SB(1, 0), cB + kstep, voffB); PG8_STAGE(PG8_SA(1, 0), cA + kstep, voffA); PG8_STAGE(PG8_SB(1, 1), cB + hstep + kstep, voffB);
        PG8_WAIT_V(6); PG8_BAR;
    } else {
        PG8_STAGE(PG8_SB(0, 0), cB, voffB); PG8_STAGE(PG8_SA(0, 0), cA, voffA); PG8_STAGE(PG8_SB(0, 1), cB + hstep, voffB); PG8_STAGE(PG8_SA(0, 1), cA + hstep, voffA);
        if (wr == 1) PG8_BAR;
        PG8_WAIT_V(4); PG8_BAR;
        PG8_STAGE(PG8_SB(1, 0), cB + kstep, voffB); PG8_STAGE(PG8_SA(1, 0), cA + kstep, voffA); PG8_STAGE(PG8_SB(1, 1), cB + hstep + kstep, voffB);
        PG8_WAIT_V(6); PG8_BAR;
    }
    for (;;) {
        const bool has_next = S.next(ui + 1, nxt);
        const char* nA = has_next ? (const char*)g.A + (size_t)nxt.pm * tstep + (size_t)nxt.k0 * 2 : cA; const char* nB = has_next ? (const char*)g.Bt + (size_t)nxt.pn * tstep + (size_t)nxt.k0 * 2 : cB;
        const int nt = cur.nt ? cur.nt : ntf;
        for (int t = 0; t < nt; t += 2) {
            const bool last = (t == nt - 2);
            const char* a1 = cA + (size_t)(t + 1) * kstep;
            const char* a2 = last ? nA : cA + (size_t)(t + 2) * kstep; const char* b2 = last ? nB : cB + (size_t)(t + 2) * kstep;
            const char* a3 = a2 + kstep; const char* b3 = b2 + kstep;
            if (last && has_next) S.a_ready(nxt);
            if constexpr (SP2) {
            PG8_LDB(B0, 0, 0); PG8_LDB(B1, 0, 1); PG8_SCHED; PG8_LDA(At, 0, 0); PG8_STAGE(PG8_SA(1, 1), a1 + hstep, voffA);
            PG8_WAIT_V(8); PG8_WAIT_L(0); PG8_BAR; PG8_MMA(0, 0, At, B0); PG8_MMA(0, 1, At, B1); PG8_BAR; PG8_SCHED;
            PG8_LDA(At, 0, 1); PG8_STAGE(PG8_SB(0, 0), b2, voffB); PG8_STAGE(PG8_SB(0, 1), b2 + hstep, voffB); PG8_STAGE(PG8_SA(0, 0), a2, voffA);
            PG8_WAIT_V(8); PG8_WAIT_L(0); PG8_BAR; PG8_MMA(1, 0, At, B0); PG8_MMA(1, 1, At, B1); PG8_BAR; PG8_SCHED;
            PG8_LDB(B0, 1, 0); PG8_LDB(B1, 1, 1); PG8_SCHED; PG8_LDA(At, 1, 0); PG8_STAGE(PG8_SA(0, 1), a2 + hstep, voffA);
            PG8_WAIT_V(8); PG8_WAIT_L(0); PG8_BAR; PG8_MMA(0, 0, At, B0); PG8_MMA(0, 1, At, B1); PG8_BAR; PG8_SCHED;
            PG8_LDA(At, 1, 1); PG8_STAGE(PG8_SB(1, 0), b3, voffB); PG8_STAGE(PG8_SB(1, 1), b3 + hstep, voffB); PG8_STAGE(PG8_SA(1, 0), a3, voffA);
            PG8_WAIT_V(8); PG8_WAIT_L(0); PG8_BAR; PG8_MMA(1, 0, At, B0); PG8_MMA(1, 1, At, B1); PG8_BAR; PG8_SCHED;
            } else {
            PG8_LDB(B0, 0, 0); PG8_SCHED; PG8_LDA(At, 0, 0); PG8_STAGE(PG8_SA(1, 1), a1 + hstep, voffA);
            PG8_WAIT_L(8); PG8_BAR; PG8_WAIT_L(0); PG8_MMA(0, 0, At, B0); PG8_BAR; PG8_SCHED;
            PG8_LDB(B1, 0, 1); PG8_STAGE(PG8_SB(0, 0), b2, voffB);
            PG8_BAR; PG8_WAIT_L(0); PG8_MMA(0, 1, At, B1); PG8_BAR;
            PG8_LDA(At, 0, 1); PG8_STAGE(PG8_SA(0, 0), a2, voffA);
            PG8_BAR; PG8_WAIT_L(0); PG8_MMA(1, 0, At, B0); PG8_BAR; PG8_SCHED;
            PG8_STAGE(PG8_SB(0, 1), b2 + hstep, voffB);
            PG8_WAIT_V(6); PG8_BAR; PG8_MMA(1, 1, At, B1); PG8_BAR;
            PG8_LDB(B0, 1, 0); PG8_SCHED; PG8_LDA(At, 1, 0); PG8_STAGE(PG8_SA(0, 1), a2 + hstep, voffA);
            PG8_WAIT_L(8); PG8_BAR; PG8_WAIT_L(0); PG8_MMA(0, 0, At, B0); PG8_BAR; PG8_SCHED;
            PG8_LDB(B1, 1, 1); PG8_STAGE(PG8_SB(1, 0), b3, voffB);
            PG8_BAR; PG8_WAIT_L(0); PG8_MMA(0, 1, At, B1); PG8_BAR;
            PG8_LDA(At, 1, 1); PG8_STAGE(PG8_SA(1, 0), a3, voffA);
            PG8_BAR; PG8_WAIT_L(0); PG8_MMA(1, 0, At, B0); PG8_BAR; PG8_SCHED;
            PG8_STAGE(PG8_SB(1, 1), b3 + hstep, voffB);
            PG8_WAIT_V(6); PG8_BAR; PG8_MMA(1, 1, At, B1); PG8_BAR;
            }
        }
        if constexpr (ALIGN_EPI) { if (wr == 0) PG8_BAR; }
        if constexpr (!Epi::AFTER_DRAIN) { E(acc, cur, wr, wc, fr, fq); S.done(cur); }
        if (!has_next) break;
#pragma unroll
        for (int a = 0; a < 2; ++a)
#pragma unroll
            for (int b = 0; b < 2; ++b)
#pragma unroll
                for (int m = 0; m < 4; ++m)
#pragma unroll
                    for (int n = 0; n < 2; ++n) acc[a][b][m][n] = (f32x4){0.f, 0.f, 0.f, 0.f};
        cur = nxt; cA = nA; cB = nB; ++ui;
        if constexpr (ALIGN_EPI) { if (wr == 1) PG8_BAR; }
    }
    PG8_WAIT_V(0);
    if constexpr (!ALIGN_EPI) { if (wr == 0) PG8_BAR; }
    PG8_BAR;
    if constexpr (Epi::AFTER_DRAIN) { E.fused(acc, cur, wr, wc, fr, fq, lds, wid, lane); S.done(cur); }
#undef PG8_SA
#undef PG8_SB
#undef PG8_STAGE
#undef PG8_LDA
#undef PG8_LDB
#undef PG8_MMA
#undef PG8_WAIT_V
#undef PG8_WAIT_L
#undef PG8_BAR
#undef PG8_SCHED
}
}

#define LAS __attribute__((address_space(3)))
constexpr int NB = 4, SEQ = 8192, DM = 1024, NCTX = 256, NHEAD = 16, DFF = 4096;
constexpr int MLAT = NB * SEQ;
constexpr int MCTX = NB * NCTX;
constexpr int MALL = MLAT + MCTX;
constexpr float EPS = 1e-6f;
constexpr float LOG2E = 1.4426950408889634f;
constexpr float QSCALE = 0.125f * LOG2E;
constexpr float NEGBIG = -1e30f;

constexpr size_t MiB = 1u << 20;
constexpr size_t WS_MODS = 1 * MiB;
constexpr size_t WS_ROPE = 1 * MiB + 512 * 1024;
constexpr size_t WS_GAINS = 1 * MiB + 768 * 1024;
constexpr size_t WS_BND = 1 * MiB + 896 * 1024;
constexpr size_t WS_BAR = 64 * 1024;
constexpr size_t WS_ARGS = 0;
constexpr size_t WS_WQKV0 = 2 * MiB, WS_WO0 = 8 * MiB, WS_WQKV1 = 10 * MiB, WS_WO1 = 13 * MiB, WS_W1 = 16 * MiB, WS_W2 = 32 * MiB;
constexpr size_t WS_HC = 48 * MiB;
constexpr size_t WS_U = 52 * MiB;
constexpr size_t WS_Q = 118 * MiB, WS_K = 184 * MiB, WS_V = 250 * MiB, WS_O = 316 * MiB;
constexpr size_t WS_HMID = 118 * MiB;
constexpr size_t WS_PART = 382 * MiB;
constexpr size_t WS_HB = 446 * MiB;
constexpr size_t WS_END = 510 * MiB;

typedef pg8::f32x4 f32x4;
typedef pg8::bf16x8 bf16x8;
typedef unsigned short bf16_t;
typedef unsigned u32x4 __attribute__((ext_vector_type(4)));
typedef unsigned u32x2 __attribute__((ext_vector_type(2)));
typedef float f32x2_t __attribute__((ext_vector_type(2)));
typedef __bf16 bf16x2_t __attribute__((ext_vector_type(2)));
typedef short s16x4 __attribute__((ext_vector_type(4)));
__device__ __forceinline__ unsigned pkbf(float lo, float hi) { f32x2_t v = {lo, hi}; bf16x2_t b = __builtin_convertvector(v, bf16x2_t); return __builtin_bit_cast(unsigned, b); }

template <int CTRL> __device__ __forceinline__ float dppf(float v) { return __uint_as_float((unsigned)__builtin_amdgcn_update_dpp(0, (int)__float_as_uint(v), CTRL, 0xF, 0xF, true)); }
__device__ __forceinline__ float xsum4(float v) {
    auto a = __builtin_amdgcn_permlane16_swap(__float_as_uint(v), __float_as_uint(v), false, false);
    v = __uint_as_float(a[0]) + __uint_as_float(a[1]);
    auto b = __builtin_amdgcn_permlane32_swap(__float_as_uint(v), __float_as_uint(v), false, false);
    return __uint_as_float(b[0]) + __uint_as_float(b[1]);
}
__device__ __forceinline__ float wave_sum64(float v) {
    v += dppf<0xB1>(v); v += dppf<0x4E>(v); v += dppf<0x141>(v); v += dppf<0x140>(v);
    return xsum4(v);
}

struct EpiRelu2 {
    static constexpr bool PERM = true, AFTER_DRAIN = false;
    bf16_t* O; int ldc;
    __device__ __forceinline__ void operator()(const f32x4 (&acc)[2][2][4][2], const pg8::Unit& u, int wr, int wc, int fr, int fq) const {
        const int row0 = u.pm * 256 + wr * 64 + fr, col0 = u.pn * 256 + wc * 32 + 8 * fq;
#pragma unroll
        for (int ai = 0; ai < 2; ++ai)
#pragma unroll
            for (int m = 0; m < 4; ++m) { bf16_t* rowp = O + (size_t)(row0 + ai * 128 + m * 16) * ldc + col0;
#pragma unroll
                for (int bj = 0; bj < 2; ++bj) { f32x4 v0 = acc[ai][bj][m][0], v1 = acc[ai][bj][m][1];
#pragma unroll
                    for (int i = 0; i < 4; ++i) { float a = fmaxf(v0[i], 0.f), b = fmaxf(v1[i], 0.f); v0[i] = a * a; v1[i] = b * b; }
                    u32x4 w; w.x = pkbf(v0[0], v0[1]); w.y = pkbf(v0[2], v0[3]); w.z = pkbf(v1[0], v1[1]); w.w = pkbf(v1[2], v1[3]);
                    *(u32x4*)(rowp + bj * 128) = w; } }
    }
};
struct SplitOrder {
    pg8::StaticOrder lat; int S, ntc;
    __device__ void init(int N, int K, int S_, int G_, int c_) { lat.init(MLAT, N, G_, c_); S = S_; ntc = S_ ? K / 64 / S_ : 0; }
    __device__ bool next(int i, pg8::Unit& u) const {
        if (lat.next(i, u)) return true;
        const int j = i * lat.G + lat.c - lat.nwg; if (j >= 16 * S) return false;
        const int tile = j / S, ch = j - tile * S; u.pm = 128 + (tile >> 2); u.pn = tile & 3; u.k0 = ch * ntc * 64; u.nt = ntc; return true;
    }
    __device__ __forceinline__ void a_ready(const pg8::Unit&) const {}
    __device__ __forceinline__ void done(const pg8::Unit&) const {}
};
struct EpiRes {
    static constexpr bool PERM = true, AFTER_DRAIN = false;
    const void* base_lat; const float* base_ctx; void* out_lat; float* out_ctx; const float* gate; float* part; int base_f32, out_f32;
    __device__ __forceinline__ void operator()(const f32x4 (&acc)[2][2][4][2], const pg8::Unit& u, int wr, int wc, int fr, int fq) const {
        const bool isctx = u.pm >= 128; const int s = isctx ? 4 : (u.pm >> 5);
        const int col0 = u.pn * 256 + wc * 32 + 8 * fq;
        const float* gp = gate + s * 6144 + col0;
        int row0 = (isctx ? u.pm - 128 : u.pm) * 256 + wr * 64 + fr; asm volatile("" : "+v"(row0));
        f32x4 g[2][2];
#pragma unroll
        for (int bj = 0; bj < 2; ++bj) { g[bj][0] = *(const f32x4*)(gp + bj * 128); g[bj][1] = *(const f32x4*)(gp + bj * 128 + 4); }
        if (u.nt != 0) {
            float* pp = part + (size_t)(u.k0 / (u.nt * 64)) * MCTX * DM;
#pragma unroll
            for (int ai = 0; ai < 2; ++ai)
#pragma unroll
                for (int m = 0; m < 4; ++m) { float* o = pp + (size_t)(row0 + ai * 128 + m * 16) * DM + col0;
#pragma unroll
                    for (int bj = 0; bj < 2; ++bj)
#pragma unroll
                        for (int n = 0; n < 2; ++n) *(f32x4*)(o + bj * 128 + 4 * n) = g[bj][n] * acc[ai][bj][m][n]; }
            return;
        }
        const bool bf = isctx || base_f32, of = isctx || out_f32;
        const float* bpf = isctx ? base_ctx : (const float*)base_lat; float* opf = isctx ? out_ctx : (float*)out_lat;
        const bf16_t* bph = (const bf16_t*)base_lat; bf16_t* oph = (bf16_t*)out_lat;
#pragma unroll
        for (int ai = 0; ai < 2; ++ai)
#pragma unroll
            for (int m = 0; m < 4; ++m) { const size_t off = (size_t)(row0 + ai * 128 + m * 16) * DM + col0;
#pragma unroll
                for (int bj = 0; bj < 2; ++bj) {
                    f32x4 b0, b1;
                    if (bf) { b0 = *(const f32x4*)(bpf + off + bj * 128); b1 = *(const f32x4*)(bpf + off + bj * 128 + 4); }
                    else { const u32x4 w = *(const u32x4*)(bph + off + bj * 128);
                        b0 = (f32x4){__uint_as_float(w.x << 16), __uint_as_float(w.x & 0xffff0000u), __uint_as_float(w.y << 16), __uint_as_float(w.y & 0xffff0000u)};
                        b1 = (f32x4){__uint_as_float(w.z << 16), __uint_as_float(w.z & 0xffff0000u), __uint_as_float(w.w << 16), __uint_as_float(w.w & 0xffff0000u)}; }
                    const f32x4 o0 = b0 + g[bj][0] * acc[ai][bj][m][0], o1 = b1 + g[bj][1] * acc[ai][bj][m][1];
                    if (of) { *(f32x4*)(opf + off + bj * 128) = o0; *(f32x4*)(opf + off + bj * 128 + 4) = o1; }
                    else { u32x4 w; w.x = pkbf(o0[0], o0[1]); w.y = pkbf(o0[2], o0[3]); w.z = pkbf(o1[0], o1[1]); w.w = pkbf(o1[2], o1[3]); *(u32x4*)(oph + off + bj * 128) = w; } } }
    }
};
struct EpiQKV {
    static constexpr bool PERM = true, AFTER_DRAIN = false;
    bf16_t* Q; size_t kstride; int kvpitch; int nk_tiles;
    const float* gains; const float* rope;
    __device__ __forceinline__ void operator()(const f32x4 (&acc)[2][2][4][2], const pg8::Unit& u, int wr, int wc, int fr, int fq) const {
        const int pn = u.pn; const int kind = pn < 4 ? 0 : (pn < 4 + nk_tiles ? 1 : 2);
        const int hd = (kind == 0 ? pn : (kind == 1 ? pn - 4 : pn - 4 - nk_tiles)) * 4 + wc;
        bf16_t* dst = Q + (size_t)kind * kstride + hd * 64 + 8 * fq; const int pitch = kind == 0 ? DM : kvpitch;
        const float* gp = gains + (kind & 1) * 64 + 8 * fq;
        const bool dorope = (rope != nullptr) && kind < 2 && u.pm < 128;
        const float* rp = rope + 8 * (fq & 1);
        int rbase = u.pm * 256 + wr * 64 + fr; asm volatile("" : "+v"(rbase));
        const int paddr = ((fr + 16 * fq) ^ 32) << 2;
#pragma unroll
        for (int ai = 0; ai < 2; ++ai)
#pragma unroll
            for (int m = 0; m < 4; ++m) {
                const int row = rbase + ai * 128 + m * 16;
                float rs = 1.0f;
                if (kind < 2) {
                    float ss = 0.f;
#pragma unroll
                    for (int bj = 0; bj < 2; ++bj)
#pragma unroll
                        for (int n = 0; n < 2; ++n) { const f32x4 x = acc[ai][bj][m][n]; ss += (x[0] * x[0] + x[1] * x[1]) + (x[2] * x[2] + x[3] * x[3]); }
                    ss = xsum4(ss);
                    rs = rsqrtf(ss * (1.0f / 64.0f) + EPS);
                }
                const int t = row & (SEQ - 1);
#pragma unroll
                for (int bj = 0; bj < 2; ++bj) {
                    f32x4 v0 = acc[ai][bj][m][0], v1 = acc[ai][bj][m][1];
                    if (kind < 2) {
                        v0 = v0 * rs * *(const f32x4*)(gp + 32 * bj); v1 = v1 * rs * *(const f32x4*)(gp + 32 * bj + 4);
                        if (dorope) {
                            const int pos = bj ? (t & 63) : (t >> 6);
                            const f32x4 c0 = *(const f32x4*)(rp + pos * 16), c1 = *(const f32x4*)(rp + pos * 16 + 4);
                            const f32x4 s0 = *(const f32x4*)(rp + 2048 + pos * 16), s1 = *(const f32x4*)(rp + 2048 + pos * 16 + 4);
                            f32x4 o0, o1;
#pragma unroll
                            for (int i = 0; i < 4; ++i) { const float p0 = __uint_as_float((unsigned)__builtin_amdgcn_ds_bpermute(paddr, (int)__float_as_uint(v0[i]))) * s0[i], p1 = __uint_as_float((unsigned)__builtin_amdgcn_ds_bpermute(paddr, (int)__float_as_uint(v1[i]))) * s1[i];
                                o0[i] = v0[i] * c0[i] + (fq >= 2 ? p0 : -p0); o1[i] = v1[i] * c1[i] + (fq >= 2 ? p1 : -p1); }
                            v0 = o0; v1 = o1;
                        }
                    }
                    u32x4 w; w.x = pkbf(v0[0], v0[1]); w.y = pkbf(v0[2], v0[3]); w.z = pkbf(v1[0], v1[1]); w.w = pkbf(v1[2], v1[3]);
                    *(u32x4*)(dst + (size_t)row * pitch + 32 * bj) = w;
                }
                asm volatile("" ::: "memory");
            }
    }
};

namespace att {
#define DMA_SYNC() do { asm volatile("s_waitcnt vmcnt(0)" ::: "memory"); __syncthreads(); } while (0)
__device__ __forceinline__ float red_max4(float v) {
    auto a = __builtin_amdgcn_permlane16_swap(__float_as_uint(v), __float_as_uint(v), false, false);
    v = fmaxf(__uint_as_float(a[0]), __uint_as_float(a[1]));
    auto b = __builtin_amdgcn_permlane32_swap(__float_as_uint(v), __float_as_uint(v), false, false);
    return fmaxf(__uint_as_float(b[0]), __uint_as_float(b[1]));
}
__device__ __forceinline__ float red_sum4(float v) {
    auto a = __builtin_amdgcn_permlane16_swap(__float_as_uint(v), __float_as_uint(v), false, false);
    v = __uint_as_float(a[0]) + __uint_as_float(a[1]);
    auto b = __builtin_amdgcn_permlane32_swap(__float_as_uint(v), __float_as_uint(v), false, false);
    return __uint_as_float(b[0]) + __uint_as_float(b[1]);
}
typedef short v4i16_t __attribute__((ext_vector_type(4)));
__device__ __forceinline__ s16x4 vtr(const LAS unsigned char* p) { return __builtin_bit_cast(s16x4, __builtin_amdgcn_ds_read_tr16_b64_v4i16((LAS v4i16_t*)p)); }
__device__ __forceinline__ bf16x8 cat8(s16x4 a, s16x4 b) { return (bf16x8){a[0], a[1], a[2], a[3], b[0], b[1], b[2], b[3]}; }
__device__ __forceinline__ bf16x8 pack8(const f32x4& a, const f32x4& b) { u32x4 w; w.x = pkbf(a[0], a[1]); w.y = pkbf(a[2], a[3]); w.z = pkbf(b[0], b[1]); w.w = pkbf(b[2], b[3]); return __builtin_bit_cast(bf16x8, w); }

struct DmaLane { unsigned koff, voff; };
__device__ __forceinline__ DmaLane dma_lane(int pitch, int col0, int w, int lane) {
    const int key = 8 * w + (lane >> 3), slot = lane & 7;
    const int c8k = slot ^ (key & 7), c8v = (((slot >> 1) ^ ((key >> 1) & 3)) << 1) | (slot & 1);
    DmaLane d; d.koff = (unsigned)((key * pitch + col0 + c8k * 8) * 2); d.voff = (unsigned)((key * pitch + col0 + c8v * 8) * 2); return d;
}
__device__ __forceinline__ void glds16(const unsigned char* sbase, unsigned voff, unsigned lds_dst) { unsigned keep;
    asm volatile("s_mov_b32 %0, m0\n\ts_mov_b32 m0, %3\n\ts_nop 0\n\tglobal_load_lds_dwordx4 %1, %2\n\ts_mov_b32 m0, %0" : "=&s"(keep) : "v"(voff), "s"(sbase), "s"(lds_dst) : "memory"); }
template <int NHT> __device__ __forceinline__ void dma_tile(LAS unsigned char* buf, const bf16_t* Kg, const bf16_t* Vg, size_t row0, int pitch, const DmaLane& d, int w) {
    const unsigned char* kb = (const unsigned char*)Kg + row0 * (size_t)pitch * 2; const unsigned char* vb = (const unsigned char*)Vg + row0 * (size_t)pitch * 2;
    const unsigned l0 = (unsigned)__builtin_amdgcn_readfirstlane((int)(unsigned)(uintptr_t)buf + w * 1024);
#pragma unroll
    for (int hh = 0; hh < NHT; ++hh) {
        glds16(kb, d.koff + hh * 128, l0 + hh * 8192);
        glds16(vb, d.voff + hh * 128, l0 + NHT * 8192 + hh * 8192); }
}

template <int NB16> __device__ __forceinline__ float exp_step(f32x4 (&S)[NB16]) {
    float sum = 0.f;
#pragma unroll
    for (int k = 0; k < NB16; ++k)
#pragma unroll
        for (int i = 0; i < 4; ++i) { S[k][i] = __builtin_amdgcn_exp2f(S[k][i]); sum += S[k][i]; }
    return sum;
}

template <int NB16> __device__ __forceinline__ void exp_only(f32x4 (&S)[NB16]) {
#pragma unroll
    for (int k = 0; k < NB16; ++k)
#pragma unroll
        for (int i = 0; i < 4; ++i) S[k][i] = __builtin_amdgcn_exp2f(S[k][i]);
}
#define ATT_ONES ((bf16x8){16256, 16256, 16256, 16256, 16256, 16256, 16256, 16256})

template <int MASK, int GPB, int SB = 1> __device__ __forceinline__ void full_tile(f32x4 (&O)[4][4], f32x4 (&ls)[4], const bf16x8 (&qf)[4][2], float negb,
                                                            const LAS unsigned char* Kt, const LAS unsigned char* Vt, int lane, int rel0) {
    const int l15 = lane & 15, g = lane >> 4, q4 = l15 >> 2;
    const LAS unsigned char* kb0 = Kt + l15 * 128;
    const int kx0 = ((g) ^ (l15 & 7)) << 4, kx1 = ((4 + g) ^ (l15 & 7)) << 4;
    const LAS unsigned char* vrow = Vt + (4 * g + q4) * 128 + (lane & 3) * 8;
    const int swz = (2 * (g & 1) + (q4 >> 1)) & 3;
    const f32x4 cinit = (f32x4){negb, negb, negb, negb};
#pragma unroll
    for (int gh = 0; gh < 4 / GPB; ++gh) {
        f32x4 S[GPB][4];
#pragma unroll
        for (int kb = 0; kb < 4; ++kb) {
            const bf16x8 kf0 = *(const LAS bf16x8*)(kb0 + (16 * kb) * 128 + kx0), kf1 = *(const LAS bf16x8*)(kb0 + (16 * kb) * 128 + kx1);
#pragma unroll
            for (int gi = 0; gi < GPB; ++gi) { S[gi][kb] = __builtin_amdgcn_mfma_f32_16x16x32_bf16(kf0, qf[GPB * gh + gi][0], cinit, 0, 0, 0);
                S[gi][kb] = __builtin_amdgcn_mfma_f32_16x16x32_bf16(kf1, qf[GPB * gh + gi][1], S[gi][kb], 0, 0, 0); } }
        bf16x8 pf[GPB][2];
#pragma unroll
        for (int gi = 0; gi < GPB; ++gi) {
            if (MASK) {
#pragma unroll
                for (int kb = 0; kb < 4; ++kb)
#pragma unroll
                    for (int i = 0; i < 4; ++i) { const int rel = rel0 + 16 * kb + 4 * g + i; S[gi][kb][i] = ((unsigned)(rel + 128) > 256u) ? NEGBIG : S[gi][kb][i]; }
            }
            exp_only<4>(S[gi]);
            pf[gi][0] = pack8(S[gi][0], S[gi][1]); pf[gi][1] = pack8(S[gi][2], S[gi][3]);
            ls[GPB * gh + gi] = __builtin_amdgcn_mfma_f32_16x16x32_bf16(ATT_ONES, pf[gi][0], ls[GPB * gh + gi], 0, 0, 0);
            ls[GPB * gh + gi] = __builtin_amdgcn_mfma_f32_16x16x32_bf16(ATT_ONES, pf[gi][1], ls[GPB * gh + gi], 0, 0, 0);
        }
#pragma unroll
        for (int kc = 0; kc < 2; ++kc)
#pragma unroll
            for (int db = 0; db < 4; ++db) {
                const LAS unsigned char* va = vrow + ((db ^ swz) << 5) + (32 * kc) * 128;
                const bf16x8 vf = cat8(vtr(va), vtr(va + 16 * 128));
#pragma unroll
                for (int gi = 0; gi < GPB; ++gi) O[GPB * gh + gi][db] = __builtin_amdgcn_mfma_f32_16x16x32_bf16(vf, pf[gi][kc], O[GPB * gh + gi][db], 0, 0, 0);
            }
        if (SB == 1) __builtin_amdgcn_sched_barrier(0); else if (SB == 2) __builtin_amdgcn_sched_barrier(0x108);
    }
}

__device__ __forceinline__ void na_local_tile(f32x4 (&O)[4][4], f32x4 (&ls)[4], const bf16x8 (&qf)[4][2], float negb,
                                              const LAS unsigned char* Kt, const LAS unsigned char* Vt, int lane, const LAS float* bias_row, bool rowvalid) {
    const int l15 = lane & 15, g = lane >> 4, q4 = l15 >> 2;
    const LAS unsigned char* kb0 = Kt + l15 * 128;
    const int kx0 = ((g) ^ (l15 & 7)) << 4, kx1 = ((4 + g) ^ (l15 & 7)) << 4;
    const LAS unsigned char* vrow = Vt + (4 * g + q4) * 128 + (lane & 3) * 8;
    const int swz = (2 * (g & 1) + (q4 >> 1)) & 3;
#pragma unroll
    for (int grp = 0; grp < 4; ++grp) {
        const int kwin = grp == 0 ? 0 : (grp == 1 ? 8 : (grp == 2 ? 24 : 32));
        f32x4 S[2];
#pragma unroll
        for (int k2 = 0; k2 < 2; ++k2) {
            const bf16x8 kf0 = *(const LAS bf16x8*)(kb0 + (kwin + 16 * k2) * 128 + kx0), kf1 = *(const LAS bf16x8*)(kb0 + (kwin + 16 * k2) * 128 + kx1);
            S[k2] = __builtin_amdgcn_mfma_f32_16x16x32_bf16(kf0, qf[grp][0], (f32x4){negb, negb, negb, negb}, 0, 0, 0);
            S[k2] = __builtin_amdgcn_mfma_f32_16x16x32_bf16(kf1, qf[grp][1], S[k2], 0, 0, 0); }
        const int c = 16 * grp + l15; const int c0 = rowvalid ? min(max(c - 8, 0), 48) : 4096;
        const LAS float* bl = bias_row + (15 - c + 4 * g);
#pragma unroll
        for (int k2 = 0; k2 < 2; ++k2)
#pragma unroll
            for (int i = 0; i < 4; ++i) { const int kc = kwin + 16 * k2 + 4 * g + i; const float bias = bl[kwin + 16 * k2 + i];
                S[k2][i] = ((unsigned)(kc - c0) < 16u) ? S[k2][i] + bias : NEGBIG; }
        exp_only<2>(S);
        const bf16x8 pf = pack8(S[0], S[1]);
        ls[grp] = __builtin_amdgcn_mfma_f32_16x16x32_bf16(ATT_ONES, pf, ls[grp], 0, 0, 0);
#pragma unroll
        for (int db = 0; db < 4; ++db) {
            const LAS unsigned char* va = vrow + ((db ^ swz) << 5) + kwin * 128;
            const bf16x8 vf = cat8(vtr(va), vtr(va + 16 * 128));
            O[grp][db] = __builtin_amdgcn_mfma_f32_16x16x32_bf16(vf, pf, O[grp][db], 0, 0, 0);
        }
        __builtin_amdgcn_sched_barrier(0x108);
    }
}

__device__ __forceinline__ void store_group(const f32x4 (&Og)[4], float inv, bf16_t* orow, int g) {
#pragma unroll
    for (int db = 0; db < 4; ++db) { u32x2 w; w.x = pkbf(Og[db][0] * inv, Og[db][1] * inv); w.y = pkbf(Og[db][2] * inv, Og[db][3] * inv);
        *(u32x2*)(orow + 16 * db + 4 * g) = w; }
}

template <int NI> __device__ __forceinline__ void ring_wait() { asm volatile("s_waitcnt vmcnt(%0)" :: "n"(2 * NI) : "memory"); __syncthreads(); }
__device__ __forceinline__ void drain_wait() { asm volatile("s_waitcnt vmcnt(0)" ::: "memory"); __syncthreads(); }
__device__ __forceinline__ int item_of(int it, int nmain, int ntotal) {
    const int bid = blockIdx.x, G = gridDim.x;
    if (G == 256 && nmain == 1024) { if (it < 4) return 128 * (bid & 7) + 32 * it + (bid >> 3); const int e = nmain + (it - 4) * 256 + bid; return e < ntotal ? e : -1; }
    const int e = bid + it * G; return e < ntotal ? e : -1;
}

constexpr int NA_BUF = 32768;
constexpr int NA_TAB = 4 * NA_BUF;
constexpr int NA_ITEMS_LAT = NB * 8 * 32, NA_ITEMS = NA_ITEMS_LAT + NB * 8;
__device__ __forceinline__ void na_phase(LAS unsigned char* lds, const bf16_t* Q, const bf16_t* K, const bf16_t* V, bf16_t* Ob, const float* rpb, float negb) {
    int tid_ = threadIdx.x; asm volatile("" : "+v"(tid_));
    const int tid = tid_, lane = tid & 63, w = __builtin_amdgcn_readfirstlane(tid >> 6), l15 = lane & 15, g = lane >> 4;
    LAS float* tab = (LAS float*)(lds + NA_TAB);
    for (int it = 0;; ++it) {
        const int item = item_of(it, NA_ITEMS_LAT, NA_ITEMS); if (item < 0) break;
        const bool isctx = item >= NA_ITEMS_LAT;
        int b, hp, rq;
        if (!isctx) { b = item >> 8; hp = (item >> 5) & 7; rq = item & 31; } else { const int j = item - NA_ITEMS_LAT; b = j >> 3; hp = j & 7; rq = 0; }
        const int hh = w >> 2, head = 2 * hp + hh;
        const size_t ctx0 = (size_t)(MLAT + b * NCTX), lat0 = (size_t)(b * SEQ);
        const int kr_lo = min(max(4 * rq - 4, 0), 120), kr_hi = min(max(4 * rq - 1, 0), 120) + 8;
        const int NT = 4 + (isctx ? 0 : kr_hi - kr_lo);
        const DmaLane dl = dma_lane(DM, hp * 128, w, lane);
#define NA_ROW0(t) ((t) < 4 ? ctx0 + 64 * (t) : ((t) < NT ? lat0 + (size_t)(kr_lo + (t) - 4) * 64 : ctx0))
        dma_tile<2>(lds, K, V, NA_ROW0(0), DM, dl, w);
        dma_tile<2>(lds + NA_BUF, K, V, NA_ROW0(1), DM, dl, w);
        dma_tile<2>(lds + 2 * NA_BUF, K, V, NA_ROW0(2), DM, dl, w);
        for (int i = tid; i < 2 * 465; i += 512) { const int h2 = i / 465, e = i - h2 * 465; tab[h2 * 512 + e] = rpb[(2 * hp + h2) * 465 + e] * LOG2E; }
        const int r = 4 * rq + (w & 3);
        const size_t qrow0 = isctx ? (size_t)(MLAT + b * NCTX + (w & 3) * 64) : (size_t)(b * SEQ + r * 64);
        bf16x8 qf[4][2];
#pragma unroll
        for (int grp = 0; grp < 4; ++grp)
#pragma unroll
            for (int ds = 0; ds < 2; ++ds) qf[grp][ds] = *(const bf16x8*)(Q + (qrow0 + 16 * grp + l15) * DM + head * 64 + 32 * ds + 8 * g);
        f32x4 O[4][4]; f32x4 ls[4];
#pragma unroll
        for (int grp = 0; grp < 4; ++grp) { ls[grp] = (f32x4){0.f, 0.f, 0.f, 0.f};
#pragma unroll
            for (int db = 0; db < 4; ++db) O[grp][db] = (f32x4){0.f, 0.f, 0.f, 0.f}; }
        const int r0w = min(max(r - 4, 0), 120);
        drain_wait();
        for (int t = 0; t < 4; ++t) {
            const LAS unsigned char* buf = lds + (t & 3) * NA_BUF;
            full_tile<0, 1, 2>(O, ls, qf, negb, buf + hh * 8192, buf + 2 * 8192 + hh * 8192, lane, 0);
            dma_tile<2>(lds + ((t + 3) & 3) * NA_BUF, K, V, NA_ROW0(t + 3), DM, dl, w);
            ring_wait<4>();
        }
        for (int t = 4; t < NT; ++t) {
            const LAS unsigned char* buf = lds + (t & 3) * NA_BUF;
            const int kr = kr_lo + t - 4; const bool rv = kr >= r0w && kr < r0w + 8;
            if (rv) na_local_tile(O, ls, qf, negb, buf + hh * 8192, buf + 2 * 8192 + hh * 8192, lane, tab + hh * 512 + (kr - r + 7) * 31, true);
            dma_tile<2>(lds + ((t + 3) & 3) * NA_BUF, K, V, NA_ROW0(t + 3), DM, dl, w);
            ring_wait<4>();
        }
#undef NA_ROW0
#pragma unroll
        for (int grp = 0; grp < 4; ++grp) { const float lt = ls[grp][0]; store_group(O[grp], __builtin_amdgcn_rcpf(lt), Ob + (qrow0 + 16 * grp + l15) * DM + head * 64, g); }
    }
}

constexpr int SW_BUF = 16384;
constexpr int SW_ITEMS = NB * 4 * 64;
__device__ __forceinline__ void swa_phase(LAS unsigned char* lds, const bf16_t* Q, const bf16_t* K, const bf16_t* V, bf16_t* Ob, const float* sink, float negb) {
    int tid_ = threadIdx.x; asm volatile("" : "+v"(tid_));
    const int tid = tid_, lane = tid & 63, w = __builtin_amdgcn_readfirstlane(tid >> 6), l15 = lane & 15, g = lane >> 4;
    for (int it = 0;; ++it) {
        const int item = item_of(it, SW_ITEMS, SW_ITEMS); if (item < 0) break;
        const int b = item >> 8, kvh = (item >> 6) & 3, tb = item & 63;
        const size_t ctx0 = (size_t)(MLAT + b * NCTX), lat0 = (size_t)(b * SEQ);
        const int i_lo = tb == 0 ? 2 : 0, i_hi = tb == 63 ? 4 : 6;
        const int NT = 4 + (i_hi - i_lo);
        const DmaLane dl = dma_lane(256, kvh * 64, w, lane);
#define SW_ROW0(t) ((t) < 4 ? ctx0 + 64 * (t) : ((t) < NT ? lat0 + (size_t)(128 * tb - 128 + 64 * (i_lo + (t) - 4)) : ctx0))
        dma_tile<1>(lds, K, V, SW_ROW0(0), 256, dl, w);
        dma_tile<1>(lds + SW_BUF, K, V, SW_ROW0(1), 256, dl, w);
        dma_tile<1>(lds + 2 * SW_BUF, K, V, SW_ROW0(2), 256, dl, w);
        const int tq = 128 * tb + 16 * w;
        const size_t qrow = (size_t)(b * SEQ + tq + l15);
        bf16x8 qf[4][2];
#pragma unroll
        for (int grp = 0; grp < 4; ++grp)
#pragma unroll
            for (int ds = 0; ds < 2; ++ds) qf[grp][ds] = *(const bf16x8*)(Q + qrow * DM + (4 * kvh + grp) * 64 + 32 * ds + 8 * g);
        f32x4 O[4][4]; f32x4 ls[4];
#pragma unroll
        for (int grp = 0; grp < 4; ++grp) { ls[grp] = (f32x4){0.f, 0.f, 0.f, 0.f};
#pragma unroll
            for (int db = 0; db < 4; ++db) O[grp][db] = (f32x4){0.f, 0.f, 0.f, 0.f}; }
        drain_wait();
        for (int t = 0; t < 4; ++t) {
            const LAS unsigned char* buf = lds + (t & 3) * SW_BUF;
            full_tile<0, 2, 2>(O, ls, qf, negb, buf, buf + 8192, lane, 0);
            dma_tile<1>(lds + ((t + 3) & 3) * SW_BUF, K, V, SW_ROW0(t + 3), 256, dl, w);
            ring_wait<2>();
        }
        for (int t = 4; t < NT; ++t) {
            const LAS unsigned char* buf = lds + (t & 3) * SW_BUF;
            const int start = 128 * tb - 128 + 64 * (i_lo + t - 4);
            if (start + 63 >= tq - 128 && start <= tq + 15 + 128)
                full_tile<1, 2, 2>(O, ls, qf, negb, buf, buf + 8192, lane, start - (tq + l15));
            dma_tile<1>(lds + ((t + 3) & 3) * SW_BUF, K, V, SW_ROW0(t + 3), 256, dl, w);
            ring_wait<2>();
        }
#undef SW_ROW0
#pragma unroll
        for (int grp = 0; grp < 4; ++grp) { const float lt = ls[grp][0] + __builtin_amdgcn_exp2f(sink[4 * kvh + grp] * LOG2E + negb);
            store_group(O[grp], __builtin_amdgcn_rcpf(lt), Ob + qrow * DM + (4 * kvh + grp) * 64, g); }
    }
}
}

__device__ __forceinline__ float wave_sum(float v) {
#pragma unroll
    for (int o = 1; o < 64; o <<= 1) v += __shfl_xor(v, o);
    return v;
}
__device__ __forceinline__ void transpose_item(const float* W, int K, int N, bf16_t* WT, bool perm, LAS float* scr, int item, int lane) {
    const int nblk = N / 32, kb = item / nblk, nb = item % nblk, k0 = 64 * kb, n0 = 32 * nb;
    const int r0 = perm ? ((n0 & ~255) + 128 * ((n0 >> 5) & 1) + 32 * ((n0 >> 6) & 3)) : n0;
#pragma unroll
    for (int i = 0; i < 32; ++i) { const int kk = 2 * i + (lane >> 5); scr[kk * 33 + (lane & 31)] = W[(size_t)(k0 + kk) * N + n0 + (lane & 31)]; }
    asm volatile("s_waitcnt lgkmcnt(0)" ::: "memory");
    const int c = lane & 7;
#pragma unroll
    for (int j = 0; j < 4; ++j) { const int n = (lane >> 3) + 8 * j; const LAS float* s = scr + (8 * c) * 33 + n;
        u32x4 o; o.x = pkbf(s[0 * 33], s[1 * 33]); o.y = pkbf(s[2 * 33], s[3 * 33]); o.z = pkbf(s[4 * 33], s[5 * 33]); o.w = pkbf(s[6 * 33], s[7 * 33]);
        *(u32x4*)(WT + (size_t)(r0 + n) * K + k0 + 8 * c) = o; }
    asm volatile("s_waitcnt lgkmcnt(0)" ::: "memory");
}

struct Args {
    const float *x, *c, *ctx, *c_ctx, *ada_w, *ada_b, *g_mix, *g_mlp, *mlp_w1, *mlp_w2, *na_wqkv, *na_q_gain, *na_k_gain, *na_rpb, *na_wo,
                *swa_wqkv, *swa_q_gain, *swa_k_gain, *swa_sink, *swa_wo;
    float* out; unsigned char* ws;
};

__device__ __forceinline__ void prologue_phase(const Args& a, LAS unsigned char* lds) {
    const int tid = threadIdx.x, lane = tid & 63, w = __builtin_amdgcn_readfirstlane(tid >> 6);
    float* mods = (float*)(a.ws + WS_MODS);
    if (blockIdx.x < 96) {
        const int l = blockIdx.x / 48, cgp = blockIdx.x % 48; const int j = 128 * cgp + 2 * lane;
        LAS float* sil = (LAS float*)(lds + 32768);
        for (int i = tid; i < 5 * DM; i += 512) { const float cv = i < 4 * DM ? a.c[i] : a.c_ctx[i - 4 * DM]; sil[i] = cv / (1.0f + __expf(-cv)); }
        __syncthreads();
        float acc[5][2];
#pragma unroll
        for (int s = 0; s < 5; ++s) { acc[s][0] = 0.f; acc[s][1] = 0.f; }
        const float* wp = a.ada_w + ((size_t)l * DM + 128 * w) * 6144 + j;
#pragma unroll 8
        for (int kk = 0; kk < 128; ++kk) { const int k = 128 * w + kk; const f32x2_t wv = *(const f32x2_t*)(wp + (size_t)kk * 6144);
#pragma unroll
            for (int s = 0; s < 5; ++s) { const float sv = sil[s * DM + k]; acc[s][0] += sv * wv.x; acc[s][1] += sv * wv.y; } }
        LAS float* part = (LAS float*)lds;
#pragma unroll
        for (int s = 0; s < 5; ++s) { part[(w * 5 + s) * 128 + 2 * lane] = acc[s][0]; part[(w * 5 + s) * 128 + 2 * lane + 1] = acc[s][1]; }
        __syncthreads();
        for (int idx = tid; idx < 640; idx += 512) { const int s = idx >> 7, col = idx & 127; float t = 0.f;
#pragma unroll
            for (int ww = 0; ww < 8; ++ww) t += part[(ww * 5 + s) * 128 + col];
            mods[(l * 5 + s) * 6144 + 128 * cgp + col] = t + a.ada_b[l * 6144 + 128 * cgp + col]; }
        __syncthreads();
    } else if (blockIdx.x == 96) {
        float* rope = (float*)(a.ws + WS_ROPE);
        for (int idx = tid; idx < 2048; idx += 512) { const int pos = idx >> 4, f = idx & 15;
            const float inv = exp2f(-(float)f * (13.287712379549449f / 16.0f)); const float ang = (float)pos * inv;
            float xr = ang * 0.15915494309189535f; xr -= floorf(xr);
            rope[idx] = __builtin_amdgcn_cosf(xr); rope[2048 + idx] = __builtin_amdgcn_sinf(xr); }
        float* gains = (float*)(a.ws + WS_GAINS);
        if (tid < 256) { const int l = tid >> 7, k = (tid >> 6) & 1, d = tid & 63;
            const float* src = l == 0 ? (k == 0 ? a.na_q_gain : a.na_k_gain) : (k == 0 ? a.swa_q_gain : a.swa_k_gain);
            gains[tid] = src[d] * (k == 0 ? QSCALE : 1.0f); }
        if (tid == 0) *(Args*)(a.ws + WS_ARGS) = a;
        float mxb = -1e30f;
        for (int i = tid; i < NHEAD * 465; i += 512) mxb = fmaxf(mxb, a.na_rpb[i]);
#pragma unroll
        for (int o = 1; o < 64; o <<= 1) mxb = fmaxf(mxb, __shfl_xor(mxb, o));
        LAS float* red = (LAS float*)lds;
        if (lane == 0) red[w] = mxb;
        __syncthreads();
        if (w == 0) {
            float g0 = fabsf(a.na_q_gain[lane]), g1 = fabsf(a.na_k_gain[lane]), g2 = fabsf(a.swa_q_gain[lane]), g3 = fabsf(a.swa_k_gain[lane]);
#pragma unroll
            for (int o = 1; o < 64; o <<= 1) { g0 = fmaxf(g0, __shfl_xor(g0, o)); g1 = fmaxf(g1, __shfl_xor(g1, o)); g2 = fmaxf(g2, __shfl_xor(g2, o)); g3 = fmaxf(g3, __shfl_xor(g3, o)); }
            float mb = red[0];
#pragma unroll
            for (int i = 1; i < 8; ++i) mb = fmaxf(mb, red[i]);
            if (lane == 0) { float* bnd = (float*)(a.ws + WS_BND); bnd[0] = (8.0f * g0 * g1 + fmaxf(mb, 0.f)) * LOG2E; bnd[1] = 8.0f * g2 * g3 * LOG2E; }
        }
        __syncthreads();
    }
    LAS float* scr = (LAS float*)(lds + w * 16384);
    const int gw = blockIdx.x * 8 + w, ngw = gridDim.x * 8;
    constexpr int I_QKV0 = 16 * 96, I_WO = 16 * 32, I_QKV1 = 16 * 48, I_W1 = 16 * 128, I_W2 = 64 * 32;
    constexpr int NITEMS = I_QKV0 + 2 * I_WO + I_QKV1 + 2 * I_W1 + 2 * I_W2;
    constexpr int HCAP = 2; const int nfree = ((int)gridDim.x > 96 ? (int)gridDim.x - 96 : 0) * 8, pre = nfree * HCAP < NITEMS ? nfree * HCAP : 0;
    const int fw = ((int)blockIdx.x - 96) * 8 + w;
    for (int k = 0;; ++k) {
        int it;
        if (pre && k < HCAP) { if ((int)blockIdx.x < 96) continue; it = fw + k * nfree; }
        else { it = pre + gw + (k - (pre ? HCAP : 0)) * ngw; if (it >= NITEMS) break; }
        int r = it;
        if (r < I_QKV0) { transpose_item(a.na_wqkv, DM, 3072, (bf16_t*)(a.ws + WS_WQKV0), true, scr, r, lane); continue; } r -= I_QKV0;
        if (r < I_WO) { transpose_item(a.na_wo, DM, DM, (bf16_t*)(a.ws + WS_WO0), false, scr, r, lane); continue; } r -= I_WO;
        if (r < I_QKV1) { transpose_item(a.swa_wqkv, DM, 1536, (bf16_t*)(a.ws + WS_WQKV1), true, scr, r, lane); continue; } r -= I_QKV1;
        if (r < I_WO) { transpose_item(a.swa_wo, DM, DM, (bf16_t*)(a.ws + WS_WO1), false, scr, r, lane); continue; } r -= I_WO;
        if (r < 2 * I_W1) { const int l = r / I_W1; transpose_item(a.mlp_w1 + (size_t)l * DM * DFF, DM, DFF, (bf16_t*)(a.ws + WS_W1) + (size_t)l * DM * DFF, false, scr, r % I_W1, lane); continue; } r -= 2 * I_W1;
        { const int l = r / I_W2; transpose_item(a.mlp_w2 + (size_t)l * DM * DFF, DFF, DM, (bf16_t*)(a.ws + WS_W2) + (size_t)l * DM * DFF, false, scr, r % I_W2, lane); }
    }
}

__device__ __forceinline__ void norm_phase(const void* src_lat, int lat_f32, const float* src_ctx, int nrows, const float* gvec, const float* mods_l, int sh_off, int sc_off, bf16_t* U, const float* part, int nparts, float* ctx_out) {
    int tid_ = threadIdx.x; asm volatile("" : "+v"(tid_));
    const int lane = tid_ & 63, w = __builtin_amdgcn_readfirstlane(tid_ >> 6);
    const int gw = blockIdx.x * 8 + w, ngw = gridDim.x * 8;

    f32x4 gv[4];
#pragma unroll
    for (int j = 0; j < 4; ++j) gv[j] = *(const f32x4*)(gvec + 4 * lane + 256 * j);
    for (int row = gw; row < nrows; row += ngw) {
        const int s = row < MLAT ? (row >> 13) : 4;
        f32x4 v[4]; float ss = 0.f;
        if (row < MLAT && !lat_f32) { const bf16_t* src = (const bf16_t*)src_lat + (size_t)row * DM + 4 * lane;
#pragma unroll
            for (int j = 0; j < 4; ++j) { const u32x2 w = *(const u32x2*)(src + 256 * j);
                v[j] = (f32x4){__uint_as_float(w.x << 16), __uint_as_float(w.x & 0xffff0000u), __uint_as_float(w.y << 16), __uint_as_float(w.y & 0xffff0000u)}; } }
        else { const float* src = row < MLAT ? (const float*)src_lat + (size_t)row * DM : src_ctx + (size_t)(row - MLAT) * DM;
#pragma unroll
            for (int j = 0; j < 4; ++j) v[j] = *(const f32x4*)(src + 4 * lane + 256 * j); }
#pragma unroll
        for (int j = 0; j < 4; ++j) { ss += (v[j][0] * v[j][0] + v[j][1] * v[j][1]) + (v[j][2] * v[j][2] + v[j][3] * v[j][3]); }
        if (nparts != 0 && row >= MLAT) {
            for (int ch = 0; ch < nparts; ch += 4) {
                f32x4 pv[4][4];
#pragma unroll
                for (int c4 = 0; c4 < 4; ++c4) { const float* pr = part + ((size_t)(ch + c4) * MCTX + (row - MLAT)) * DM + 4 * lane;
#pragma unroll
                    for (int j = 0; j < 4; ++j) pv[c4][j] = *(const f32x4*)(pr + 256 * j); }
#pragma unroll
                for (int c4 = 0; c4 < 4; ++c4)
#pragma unroll
                    for (int j = 0; j < 4; ++j) v[j] = v[j] + pv[c4][j]; }
            ss = 0.f;
#pragma unroll
            for (int j = 0; j < 4; ++j) { *(f32x4*)(ctx_out + (size_t)(row - MLAT) * DM + 4 * lane + 256 * j) = v[j]; ss += (v[j][0] * v[j][0] + v[j][1] * v[j][1]) + (v[j][2] * v[j][2] + v[j][3] * v[j][3]); }
        }
        const float rs = rsqrtf(wave_sum64(ss) * (1.0f / DM) + EPS);
        const float* shp = mods_l + s * 6144 + sh_off + 4 * lane; const float* scp = mods_l + s * 6144 + sc_off + 4 * lane;
        bf16_t* up = U + (size_t)row * DM + 4 * lane;
#pragma unroll
        for (int j = 0; j < 4; ++j) { const f32x4 sh = *(const f32x4*)(shp + 256 * j), sc = *(const f32x4*)(scp + 256 * j);
            const f32x4 y = v[j] * rs * gv[j] * (sc + 1.0f) + sh;
            u32x2 o; o.x = pkbf(y[0], y[1]); o.y = pkbf(y[2], y[3]); *(u32x2*)(up + 256 * j) = o; }
    }
}

#define XB_TMO      128
#define XB_XCNT(j)  (256  + 64 * (j))
#define XB_XSUB(j)  (1280 + 64 * (j))
#define XB_XGEN(j)  (2304 + 64 * (j))
#define XB_TOP      3328
#define XB_TOPGEN   3392
#define XCD_BAR_WORDS 3456
#define XB_SPIN_CAP (1u << 18)

__device__ __forceinline__ unsigned xb_ld(unsigned* p)              { return __hip_atomic_load(p, __ATOMIC_RELAXED, __HIP_MEMORY_SCOPE_AGENT); }
__device__ __forceinline__ unsigned xb_add(unsigned* p, unsigned v) { return __hip_atomic_fetch_add(p, v, __ATOMIC_RELAXED, __HIP_MEMORY_SCOPE_AGENT); }
__device__ __forceinline__ unsigned xb_xcc_id() { return (unsigned)__builtin_amdgcn_s_getreg((3 << 11) | 20) & 0xFu; }
#define XB_SPIN(cond, bar) do { unsigned _sp = 0; while (cond) { __builtin_amdgcn_s_sleep(1); \
    if ((++_sp & 255u) == 0u) { if (xb_ld(&(bar)[XB_TMO])) break; if (_sp > XB_SPIN_CAP) { atomicAdd(&(bar)[XB_TMO], 1u); break; } } } } while (0)

struct XcdBarrier {
    unsigned* bar; unsigned x;
    volatile LAS unsigned* st;
};

__device__ __forceinline__ XcdBarrier xcd_barrier_post(unsigned* bar, volatile LAS unsigned* st) {
    XcdBarrier b; b.bar = bar; b.x = xb_xcc_id(); b.st = st;
    if (threadIdx.x == 0) (void)xb_add(&bar[XB_XCNT(b.x)], 1u);
    return b;
}
__device__ __forceinline__ void xcd_barrier_complete(unsigned* bar, unsigned x, unsigned& nloc, unsigned& nx) {
    const unsigned G = gridDim.x * gridDim.y * gridDim.z;
    unsigned sum, cnt, mine, sp = 0u;
    for (;;) {
        sum = 0u; cnt = 0u; mine = 0u;
#pragma unroll
        for (unsigned j = 0; j < 16; ++j) { const unsigned c = xb_ld(&bar[XB_XCNT(j)]); sum += c; cnt += (c > 0u) ? 1u : 0u; mine = (j == x) ? c : mine; }
        if (sum == G) break;
        __builtin_amdgcn_s_sleep(1);
        if ((++sp & 255u) == 0u) { if (xb_ld(&bar[XB_TMO])) break; if (sp > XB_SPIN_CAP) { atomicAdd(&bar[XB_TMO], 1u); break; } }
    }
    nloc = mine > 0u ? mine : 1u; nx = cnt > 0u ? cnt : 1u;
}

__device__ __forceinline__ void xcd_barrier(const XcdBarrier& b) {
    asm volatile("s_waitcnt vmcnt(0)" ::: "memory");
    __syncthreads();
    if (threadIdx.x == 0) {
        unsigned* bar = b.bar;
        __builtin_amdgcn_s_waitcnt(0);
        unsigned nloc = b.st[0], nx = b.st[1];
        if (nloc == 0u) { xcd_barrier_complete(bar, b.x, nloc, nx); b.st[0] = nloc; b.st[1] = nx; }
        const unsigned old = xb_add(&bar[XB_XSUB(b.x)], 1u);
        const unsigned gen = old / nloc;
        if (old + 1u == (gen + 1u) * nloc) {
            __builtin_amdgcn_fence(__ATOMIC_RELEASE, "agent");
            asm volatile("s_waitcnt vmcnt(0)" ::: "memory");
            const unsigned og = xb_add(&bar[XB_TOP], 1u);
            const unsigned tg = og / nx;
            if (og + 1u == (tg + 1u) * nx) xb_add(&bar[XB_TOPGEN], 1u);
            else XB_SPIN(xb_ld(&bar[XB_TOPGEN]) == tg, bar);
            __builtin_amdgcn_fence(__ATOMIC_ACQUIRE, "agent");
            xb_add(&bar[XB_XGEN(b.x)], 1u);
            asm volatile("s_waitcnt vmcnt(0)" ::: "memory");
        } else {
            XB_SPIN(xb_ld(&bar[XB_XGEN(b.x)]) == gen, bar);
            __builtin_amdgcn_fence(__ATOMIC_ACQUIRE, "agent");
            asm volatile("s_waitcnt vmcnt(0)" ::: "memory");
        }
    }
    __syncthreads();
}

constexpr int LDS_BYTES = 147456;
static_assert(att::NA_TAB + 2 * 512 * 4 <= LDS_BYTES, "LDS map");

__global__ void __launch_bounds__(512, 2) fwd_megakernel(Args a) {
    extern __shared__ __attribute__((aligned(16))) unsigned char lds_raw[];
    LAS unsigned char* lds = (LAS unsigned char*)lds_raw;
#define GSYNC() cg::this_grid().sync()
    unsigned char* const ws = a.ws;
    volatile LAS unsigned* xst = (volatile LAS unsigned*)(lds + LDS_BYTES - 16);
    if (threadIdx.x < 4) xst[threadIdx.x] = 0u;
    __syncthreads();
    XcdBarrier xb0 = xcd_barrier_post((unsigned*)(ws + WS_BAR), xst); (void)xb0;
    if ((const void*)a.c == (const void*)a.ws) GSYNC();
    prologue_phase(a, lds);
#define XSYNC() do { XcdBarrier xb_; xb_.bar = (unsigned*)(ws + WS_BAR); xb_.x = xb_xcc_id(); xb_.st = (volatile LAS unsigned*)(lds + LDS_BYTES - 16); xcd_barrier(xb_); } while (0)
    XSYNC();
    const Args* A = (const Args*)(ws + WS_ARGS);
#define WSP(T, off) ((T*)(ws + (off)))
#pragma unroll 1
    for (int l = 0; l < 2; ++l) {
        const int M = l == 0 ? MALL : MLAT;
#ifndef NORM_REP
#define NORM_REP 1
#endif
#pragma unroll 1
        for (int rep = 0; rep < NORM_REP; ++rep) {
        norm_phase(l == 0 ? (const void*)A->x : (const void*)WSP(bf16_t, WS_HB), l == 0, l == 0 ? A->ctx : WSP(float, WS_HC), MALL, A->g_mix + l * DM, WSP(float, WS_MODS) + l * 5 * 6144, 0, 1024, WSP(bf16_t, WS_U), WSP(const float, WS_PART), l == 0 ? 0 : 16, WSP(float, WS_HC));
        XSYNC();
        }
        {
            const int N = l == 0 ? 3072 : 1536;
            pg8::Gemm g{WSP(bf16_t, WS_U), WSP(const bf16_t, l == 0 ? WS_WQKV0 : WS_WQKV1), MALL, N, DM}; pg8::StaticOrder S; S.init(MALL, N, gridDim.x, blockIdx.x);
            EpiQKV E{WSP(bf16_t, WS_Q), (size_t)(WS_K - WS_Q) / 2, l == 0 ? DM : 256, l == 0 ? 4 : 1, WSP(float, WS_GAINS) + l * 128, l == 0 ? nullptr : WSP(const float, WS_ROPE)};
            pg8::gemm_phase<EpiQKV, pg8::StaticOrder, true, true>(lds, g, S, E);
        }
        XSYNC();
#ifndef ATT_REP
#define ATT_REP 1
#endif
#pragma unroll 1
        for (int rep = 0; rep < ATT_REP; ++rep) {
        if (l == 0) att::na_phase(lds, WSP(bf16_t, WS_Q), WSP(bf16_t, WS_K), WSP(bf16_t, WS_V), WSP(bf16_t, WS_O), A->na_rpb, -WSP(const float, WS_BND)[0]);
        else att::swa_phase(lds, WSP(bf16_t, WS_Q), WSP(bf16_t, WS_K), WSP(bf16_t, WS_V), WSP(bf16_t, WS_O), A->swa_sink, -WSP(const float, WS_BND)[1]);
        XSYNC();
        }
        {
            pg8::Gemm g{WSP(bf16_t, WS_O), WSP(const bf16_t, l == 0 ? WS_WO0 : WS_WO1), M, DM, DM}; SplitOrder S; S.init(DM, DM, l == 0 ? 4 : 0, gridDim.x, blockIdx.x);
            EpiRes E{l == 0 ? (const void*)A->x : (const void*)WSP(bf16_t, WS_HB), WSP(float, WS_HC), WSP(bf16_t, WS_HB), WSP(float, WS_HC), WSP(float, WS_MODS) + l * 5 * 6144 + 2048, WSP(float, WS_PART), l == 0, 0};
            pg8::gemm_phase<EpiRes, SplitOrder, true, true>(lds, g, S, E);
        }
        XSYNC();
#pragma unroll 1
        for (int rep = 0; rep < NORM_REP; ++rep) {
        norm_phase(WSP(bf16_t, WS_HB), 0, l == 0 ? A->ctx : WSP(float, WS_HC), M, A->g_mlp + l * DM, WSP(float, WS_MODS) + l * 5 * 6144, 3072, 4096, WSP(bf16_t, WS_U), WSP(const float, WS_PART), l == 0 ? 4 : 0, WSP(float, WS_HC));
        XSYNC();
        }
#ifndef UP_REP
#define UP_REP 1
#endif
#pragma unroll 1
        for (int rep = 0; rep < UP_REP; ++rep) {
        if (rep) XSYNC();
        {
            pg8::Gemm g{WSP(bf16_t, WS_U), WSP(const bf16_t, WS_W1) + (size_t)l * DM * DFF, M, DFF, DM}; pg8::StaticOrder S; S.init(M, DFF, gridDim.x, blockIdx.x);
            EpiRelu2 E{WSP(bf16_t, WS_HMID), DFF};
            pg8::gemm_phase<EpiRelu2, pg8::StaticOrder, true, true>(lds, g, S, E);
        }
        }
        XSYNC();
        {
            pg8::Gemm g{WSP(bf16_t, WS_HMID), WSP(const bf16_t, WS_W2) + (size_t)l * DM * DFF, M, DM, DFF}; SplitOrder S; S.init(DM, DFF, l == 0 ? 16 : 0, gridDim.x, blockIdx.x);
            EpiRes E{WSP(bf16_t, WS_HB), WSP(float, WS_HC), l == 0 ? (void*)WSP(bf16_t, WS_HB) : (void*)A->out, WSP(float, WS_HC), WSP(float, WS_MODS) + l * 5 * 6144 + 5120, WSP(float, WS_PART), 0, l == 1};
            pg8::gemm_phase<EpiRes, SplitOrder, true, true>(lds, g, S, E);
        }
        if (l == 0) XSYNC();
    }
#undef WSP
}

extern "C" void kernel_launch(void* const* d_in, const int* in_sizes, int n_in, void* d_out, int out_size, void* d_ws, size_t ws_size, hipStream_t stream) {
    static int grid_blocks = 0;
    if (grid_blocks == 0) {
        if (n_in != 20 || out_size != MLAT * DM || ws_size < WS_END) { fprintf(stderr, "kernel_launch: unexpected shapes (n_in %d out %d ws %zu)\n", n_in, out_size, ws_size); grid_blocks = -1; return; }
        int dev = 0, cus = 0, per_cu = 0;
        hipGetDevice(&dev);
        hipDeviceGetAttribute(&cus, hipDeviceAttributeMultiprocessorCount, dev);
        hipFuncSetAttribute((const void*)fwd_megakernel, hipFuncAttributeMaxDynamicSharedMemorySize, LDS_BYTES);
        hipOccupancyMaxActiveBlocksPerMultiprocessor(&per_cu, (const void*)fwd_megakernel, 512, LDS_BYTES);
        if (per_cu < 1) { fprintf(stderr, "kernel_launch: occupancy query says %d blocks per CU\n", per_cu); per_cu = 1; }
        grid_blocks = cus * per_cu;
    }
    if (grid_blocks < 0) return;
    if (hipMemsetAsync((unsigned char*)d_ws + WS_BAR, 0, XCD_BAR_WORDS * 4, stream) != hipSuccess) { fprintf(stderr, "kernel_launch: hipMemsetAsync of the barrier words failed\n"); return; }
    Args a{};
    const float** ap = (const float**)&a;
    for (int i = 0; i < 20; ++i) ap[i] = (const float*)d_in[i];
    a.out = (float*)d_out; a.ws = (unsigned char*)d_ws;
    void* args[] = {&a};
    hipError_t e = hipLaunchCooperativeKernel((const void*)fwd_megakernel, dim3(grid_blocks), dim3(512), args, LDS_BYTES, stream);
    if (e != hipSuccess) fprintf(stderr, "cooperative launch failed: %s (grid %d)\n", hipGetErrorString(e), grid_blocks);
}
```

```cpp
#include <hip/hip_runtime.h>
#include <hip/hip_cooperative_groups.h>
#include <cstdio>
#include <cstdint>
namespace cg = cooperative_groups;
namespace pg8 {
#define PG8_LAS __attribute__((address_space(3)))
typedef unsigned short bf16_t;
typedef short bf16x8 __attribute__((ext_vector_type(8)));
typedef float f32x4 __attribute__((ext_vector_type(4)));
typedef unsigned u32x4 __attribute__((ext_vector_type(4)));
constexpr int BM = 256, BK = 64, HALF = 128, HTB = HALF * BK * 2  , STAGE_BYTES = 8 * HTB, NXCD = 8, WGM = 8;

__host__ __device__ __forceinline__ int lds_byte(int r, int c) { const int st = (r >> 4) * 2 + (c >> 5), rr = r & 15, cc = c & 31, ob = rr * 64 + cc * 2; return st * 1024 + (ob ^ (((ob >> 9) & 1) << 5)); }
__host__ __device__ __forceinline__ void stage_rc(int b, int& R, int& C) { const int st = b / 1024, sb = b % 1024, swz = sb ^ (((sb >> 9) & 1) << 5); R = (st >> 1) * 16 + swz / 64; C = (st & 1) * 32 + (swz % 64) / 2; }
__host__ __device__ __forceinline__ int perm32(int rho) { const int n = rho >> 4, i = rho & 15; return 8 * (i >> 2) + 4 * n + (i & 3); }

struct Unit { int pm, pn, k0, nt; };
struct Gemm { const bf16_t* A; const bf16_t* Bt; int M, N, K; };

struct StaticOrder {
    int nM, nN, nwg, G, c;
    __host__ __device__ void init(int M, int N, int G_, int c_) { nM = M / BM; nN = N / BM; nwg = nM * nN; G = G_; c = c_; }
    __host__ __device__ bool next(int i, Unit& u) const {
        const long L = (long)i * G + c; if (L >= nwg) return false;
        int wgid = (int)L; { const int q = nwg / NXCD, r = nwg % NXCD, xcd = wgid % NXCD, off = wgid / NXCD; wgid = (xcd < r ? xcd * (q + 1) : r * (q + 1) + (xcd - r) * q) + off; }
        const int nig = WGM * nN, gid = wgid / nig, fm = gid * WGM, gsz = (nM - fm) < WGM ? (nM - fm) : WGM;
        u.pm = fm + ((wgid % nig) % gsz); u.pn = (wgid % nig) / gsz; u.k0 = 0; u.nt = 0; return true;
    }
    __device__ __forceinline__ void a_ready(const Unit&) const {}
    __device__ __forceinline__ void done(const Unit&) const {}
};

__device__ __forceinline__ unsigned cvt_pk_bf16(float lo, float hi) { unsigned r; asm volatile("v_cvt_pk_bf16_f32 %0, %1, %2" : "=v"(r) : "v"(lo), "v"(hi)); return r; }
template <class Epi, class Sched, bool ALIGN_EPI = false, bool SP2 = false>
__device__ __forceinline__ void gemm_phase(PG8_LAS unsigned char* lds, const Gemm g, const Sched& S, const Epi& E) {
    int tid_ = threadIdx.x; asm volatile("" : "+v"(tid_));
    const int tid = tid_, wid = __builtin_amdgcn_readfirstlane(tid >> 6), lane = tid & 63, wr = wid >> 2, wc = wid & 3, fr = lane & 15, fq = lane >> 4;
    const int K = g.K, ntf = K / BK;
    unsigned voffA[2], voffB[2];
#pragma unroll
    for (int i = 0; i < 2; ++i) { int R, C; stage_rc(tid * 16 + i * 8192, R, C); const int Rb = Epi::PERM ? ((R & ~31) + perm32(R & 31)) : R;
        voffA[i] = (unsigned)(R * K + C) * 2u; voffB[i] = (unsigned)(Rb * K + C) * 2u; }
    const size_t kstep = (size_t)(BK * 2);
    const size_t hstep = (size_t)HALF * K * 2;
    const size_t tstep = 2 * hstep;
    const unsigned ldsw = (unsigned)wid * 1024u;
    const int aoff = lds_byte(wr * 64 + fr, fq * 8), boff = lds_byte(wc * 32 + fr, fq * 8);
#define PG8_SA(b, h) (((b) * 2 + (h)) * HTB)
#define PG8_SB(b, h) ((4 + (b) * 2 + (h)) * HTB)
#define PG8_STAGE(bufoff, gbase, voff) do { _Pragma("unroll") for (int _i = 0; _i < 2; ++_i) \
        __builtin_amdgcn_global_load_lds((const unsigned*)((const char*)(gbase) + (voff)[_i]), (PG8_LAS unsigned*)(lds + (bufoff) + ldsw + _i * 8192), 16, 0, 0); } while (0)
#define PG8_LDA(dst, b, h) do { _Pragma("unroll") for (int m = 0; m < 4; ++m) _Pragma("unroll") for (int k = 0; k < 2; ++k) dst[m][k] = *(const PG8_LAS bf16x8*)(lds + PG8_SA(b, h) + aoff + m * 2048 + k * 1024); } while (0)
#define PG8_LDB(dst, b, h) do { _Pragma("unroll") for (int n = 0; n < 2; ++n) _Pragma("unroll") for (int k = 0; k < 2; ++k) dst[n][k] = *(const PG8_LAS bf16x8*)(lds + PG8_SB(b, h) + boff + n * 2048 + k * 1024); } while (0)
#define PG8_MMA(ai, bj, At, Bt) do { __builtin_amdgcn_s_setprio(1); _Pragma("unroll") for (int m = 0; m < 4; ++m) _Pragma("unroll") for (int n = 0; n < 2; ++n) _Pragma("unroll") for (int k = 0; k < 2; ++k) \
        acc[ai][bj][m][n] = __builtin_amdgcn_mfma_f32_16x16x32_bf16(Bt[n][k], At[m][k], acc[ai][bj][m][n], 0, 0, 0); __builtin_amdgcn_s_setprio(0); } while (0)
#define PG8_WAIT_V(n) asm volatile("s_waitcnt vmcnt(" #n ")" ::: "memory")
#define PG8_WAIT_L(n) asm volatile("s_waitcnt lgkmcnt(" #n ")" ::: "memory")
#define PG8_BAR __builtin_amdgcn_s_barrier()
#define PG8_SCHED __builtin_amdgcn_sched_barrier(0)
    Unit cur, nxt; int ui = 0;
    if (!S.next(0, cur)) return;
    f32x4 acc[2][2][4][2];
#pragma unroll
    for (int a = 0; a < 2; ++a)
#pragma unroll
        for (int b = 0; b < 2; ++b)
#pragma unroll
            for (int m = 0; m < 4; ++m)
#pragma unroll
                for (int n = 0; n < 2; ++n) acc[a][b][m][n] = (f32x4){0.f, 0.f, 0.f, 0.f};
    bf16x8 At[4][2], B0[2][2], B1[2][2];
    const char* cA = (const char*)g.A + (size_t)cur.pm * tstep + (size_t)cur.k0 * 2; const char* cB = (const char*)g.Bt + (size_t)cur.pn * tstep + (size_t)cur.k0 * 2;
    S.a_ready(cur);
    if constexpr (SP2) {
        PG8_STAGE(PG8_SB(0, 0), cB, voffB); PG8_STAGE(PG8_SB(0, 1), cB + hstep, voffB); PG8_STAGE(PG8_SA(0, 0), cA, voffA); PG8_STAGE(PG8_SA(0, 1), cA + hstep, voffA);
        if (wr == 1) PG8_BAR;
        PG8_WAIT_V(2); PG8_BAR;
        PG8_STAGE(PG8_SB(1, 0), cB + kstep, voffB); PG8_STAGE(PG8_SA(1, 0), cA + kstep, voffA); PG8_STAGE(PG8_SB(1, 1), cB + hstep + kstep, voffB);
        PG8_WAIT_V(6); PG8_BAR;
    } else {
        PG8_STAGE(PG8_SB(0, 0), cB, voffB); PG8_STAGE(PG8_SA(0, 0), cA, voffA); PG8_STAGE(PG8_SB(0, 1), cB + hstep, voffB); PG8_STAGE(PG8_SA(0, 1), cA + hstep, voffA);
        if (wr == 1) PG8_BAR;
        PG8_WAIT_V(4); PG8_BAR;
        PG8_STAGE(PG8_SB(1, 0), cB + kstep, voffB); PG8_STAGE(PG8_SA(1, 0), cA + kstep, voffA); PG8_STAGE(PG8_SB(1, 1), cB + hstep + kstep, voffB);
        PG8_WAIT_V(6); PG8_BAR;
    }
    for (;;) {
        const bool has_next = S.next(ui + 1, nxt);
        const char* nA = has_next ? (const char*)g.A + (size_t)nxt.pm * tstep + (size_t)nxt.k0 * 2 : cA; const char* nB = has_next ? (const char*)g.Bt + (size_t)nxt.pn * tstep + (size_t)nxt.k0 * 2 : cB;
        const int nt = cur.nt ? cur.nt : ntf;
        for (int t = 0; t < nt; t += 2) {
            const bool last = (t == nt - 2);
            const char* a1 = cA + (size_t)(t + 1) * kstep;
            const char* a2 = last ? nA : cA + (size_t)(t + 2) * kstep; const char* b2 = last ? nB : cB + (size_t)(t + 2) * kstep;
            const char* a3 = a2 + kstep; const char* b3 = b2 + kstep;
            if (last && has_next) S.a_ready(nxt);
            if constexpr (SP2) {
            PG8_LDB(B0, 0, 0); PG8_LDB(B1, 0, 1); PG8_SCHED; PG8_LDA(At, 0, 0); PG8_STAGE(PG8_SA(1, 1), a1 + hstep, voffA);
            PG8_WAIT_V(8); PG8_WAIT_L(0); PG8_BAR; PG8_MMA(0, 0, At, B0); PG8_MMA(0, 1, At, B1); PG8_BAR; PG8_SCHED;
            PG8_LDA(At, 0, 1); PG8_STAGE(PG8_SB(0, 0), b2, voffB); PG8_STAGE(PG8_SB(0, 1), b2 + hstep, voffB); PG8_STAGE(PG8_SA(0, 0), a2, voffA);
            PG8_WAIT_V(8); PG8_WAIT_L(0); PG8_BAR; PG8_MMA(1, 0, At, B0); PG8_MMA(1, 1, At, B1); PG8_BAR; PG8_SCHED;
            PG8_LDB(B0, 1, 0); PG8_LDB(B1, 1, 1); PG8_SCHED; PG8_LDA(At, 1, 0); PG8_STAGE(PG8_SA(0, 1), a2 + hstep, voffA);
            PG8_WAIT_V(8); PG8_WAIT_L(0); PG8_BAR; PG8_MMA(0, 0, At, B0); PG8_MMA(0, 1, At, B1); PG8_BAR; PG8_SCHED;
            PG8_LDA(At, 1, 1); PG8_STAGE(PG8_SB(1, 0), b3, voffB); PG8_STAGE(PG8_SB(1, 1), b3 + hstep, voffB); PG8_STAGE(PG8_SA(1, 0), a3, voffA);
            PG8_WAIT_V(8); PG8_WAIT_L(0); PG8_BAR; PG8_MMA(1, 0, At, B0); PG8_MMA(1, 1, At, B1); PG8_BAR; PG8_SCHED;
            } else {
            PG8_LDB(B0, 0, 0); PG8_SCHED; PG8_LDA(At, 0, 0); PG8_STAGE(PG8_SA(1, 1), a1 + hstep, voffA);
            PG8_WAIT_L(8); PG8_BAR; PG8_WAIT_L(0); PG8_MMA(0, 0, At, B0); PG8_BAR; PG8_SCHED;
            PG8_LDB(B1, 0, 1); PG8_STAGE(PG8_SB(0, 0), b2, voffB);
            PG8_BAR; PG8_WAIT_L(0); PG8_MMA(0, 1, At, B1); PG8_BAR;
            PG8_LDA(At, 0, 1); PG8_STAGE(PG8_SA(0, 0), a2, voffA);
            PG8_BAR; PG8_WAIT_L(0); PG8_MMA(1, 0, At, B0); PG8_BAR; PG8_SCHED;
            PG8_STAGE(PG8_SB(0, 1), b2 + hstep, voffB);
            PG8_WAIT_V(6); PG8_BAR; PG8_MMA(1, 1, At, B1); PG8_BAR;
            PG8_LDB(B0, 1, 0); PG8_SCHED; PG8_LDA(At, 1, 0); PG8_STAGE(PG8_SA(0, 1), a2 + hstep, voffA);
            PG8_WAIT_L(8); PG8_BAR; PG8_WAIT_L(0); PG8_MMA(0, 0, At, B0); PG8_BAR; PG8_SCHED;
            PG8_LDB(B1, 1, 1); PG8_STAGE(PG8_SB(1, 0), b3, voffB);
            PG8_BAR; PG8_WAIT_L(0); PG8_MMA(0, 1, At, B1); PG8_BAR;
            PG8_LDA(At, 1, 1); PG8_STAGE(PG8_SA(1, 0), a3, voffA);
            PG8_BAR; PG8_WAIT_L(0); PG8_MMA(1, 0, At, B0); PG8_BAR; PG8_SCHED;
            PG8_STAGE(PG8_SB(1, 1), b3 + hstep, voffB);
            PG8_WAIT_V(6); PG8_BAR; PG8_MMA(1, 1, At, B1); PG8_BAR;
            }
        }
        if constexpr (ALIGN_EPI) { if (wr == 0) PG8_BAR; }
        if constexpr (!Epi::AFTER_DRAIN) { E(acc, cur, wr, wc, fr, fq); S.done(cur); }
        if (!has_next) break;
#pragma unroll
        for (int a = 0; a < 2; ++a)
#pragma unroll
            for (int b = 0; b < 2; ++b)
#pragma unroll
                for (int m = 0; m < 4; ++m)
#pragma unroll
                    for (int n = 0; n < 2; ++n) acc[a][b][m][n] = (f32x4){0.f, 0.f, 0.f, 0.f};
        cur = nxt; cA = nA; cB = nB; ++ui;
        if constexpr (ALIGN_EPI) { if (wr == 1) PG8_BAR; }
    }
    PG8_WAIT_V(0);
    if constexpr (!ALIGN_EPI) { if (wr == 0) PG8_BAR; }
    PG8_BAR;
    if constexpr (Epi::AFTER_DRAIN) { E.fused(acc, cur, wr, wc, fr, fq, lds, wid, lane); S.done(cur); }
#undef PG8_SA
#undef PG8_SB
#undef PG8_STAGE
#undef PG8_LDA
#undef PG8_LDB
#undef PG8_MMA
#undef PG8_WAIT_V
#undef PG8_WAIT_L
#undef PG8_BAR
#undef PG8_SCHED
}
}

#define LAS __attribute__((address_space(3)))
constexpr int NB = 4, SEQ = 8192, DM = 1024, NCTX = 256, NHEAD = 16, DFF = 4096;
constexpr int MLAT = NB * SEQ;
constexpr int MCTX = NB * NCTX;
constexpr int MALL = MLAT + MCTX;
constexpr float EPS = 1e-6f;
constexpr float LOG2E = 1.4426950408889634f;
constexpr float QSCALE = 0.125f * LOG2E;
constexpr float NEGBIG = -1e30f;

constexpr size_t MiB = 1u << 20;
constexpr size_t WS_MODS = 1 * MiB;
constexpr size_t WS_ROPE = 1 * MiB + 512 * 1024;
constexpr size_t WS_GAINS = 1 * MiB + 768 * 1024;
constexpr size_t WS_BND = 1 * MiB + 896 * 1024;
constexpr size_t WS_BAR = 64 * 1024;
constexpr size_t WS_ARGS = 0;
constexpr size_t WS_WQKV0 = 2 * MiB, WS_WO0 = 8 * MiB, WS_WQKV1 = 10 * MiB, WS_WO1 = 13 * MiB, WS_W1 = 16 * MiB, WS_W2 = 32 * MiB;
constexpr size_t WS_HC = 48 * MiB;
constexpr size_t WS_U = 52 * MiB;
constexpr size_t WS_Q = 118 * MiB, WS_K = 184 * MiB, WS_V = 250 * MiB, WS_O = 316 * MiB;
constexpr size_t WS_HMID = 118 * MiB;
constexpr size_t WS_PART = 382 * MiB;
constexpr size_t WS_HB = 446 * MiB;
constexpr size_t WS_END = 510 * MiB;

typedef pg8::f32x4 f32x4;
typedef pg8::bf16x8 bf16x8;
typedef unsigned short bf16_t;
typedef unsigned u32x4 __attribute__((ext_vector_type(4)));
typedef unsigned u32x2 __attribute__((ext_vector_type(2)));
typedef float f32x2_t __attribute__((ext_vector_type(2)));
typedef __bf16 bf16x2_t __attribute__((ext_vector_type(2)));
typedef short s16x4 __attribute__((ext_vector_type(4)));
__device__ __forceinline__ unsigned pkbf(float lo, float hi) { f32x2_t v = {lo, hi}; bf16x2_t b = __builtin_convertvector(v, bf16x2_t); return __builtin_bit_cast(unsigned, b); }

template <int CTRL> __device__ __forceinline__ float dppf(float v) { return __uint_as_float((unsigned)__builtin_amdgcn_update_dpp(0, (int)__float_as_uint(v), CTRL, 0xF, 0xF, true)); }
__device__ __forceinline__ float xsum4(float v) {
    auto a = __builtin_amdgcn_permlane16_swap(__float_as_uint(v), __float_as_uint(v), false, false);
    v = __uint_as_float(a[0]) + __uint_as_float(a[1]);
    auto b = __builtin_amdgcn_permlane32_swap(__float_as_uint(v), __float_as_uint(v), false, false);
    return __uint_as_float(b[0]) + __uint_as_float(b[1]);
}
__device__ __forceinline__ float wave_sum64(float v) {
    v += dppf<0xB1>(v); v += dppf<0x4E>(v); v += dppf<0x141>(v); v += dppf<0x140>(v);
    return xsum4(v);
}

struct EpiRelu2 {
    static constexpr bool PERM = true, AFTER_DRAIN = false;
    bf16_t* O; int ldc;
    __device__ __forceinline__ void operator()(const f32x4 (&acc)[2][2][4][2], const pg8::Unit& u, int wr, int wc, int fr, int fq) const {
        const int row0 = u.pm * 256 + wr * 64 + fr, col0 = u.pn * 256 + wc * 32 + 8 * fq;
#pragma unroll
        for (int ai = 0; ai < 2; ++ai)
#pragma unroll
            for (int m = 0; m < 4; ++m) { bf16_t* rowp = O + (size_t)(row0 + ai * 128 + m * 16) * ldc + col0;
#pragma unroll
                for (int bj = 0; bj < 2; ++bj) { f32x4 v0 = acc[ai][bj][m][0], v1 = acc[ai][bj][m][1];
#pragma unroll
                    for (int i = 0; i < 4; ++i) { float a = fmaxf(v0[i], 0.f), b = fmaxf(v1[i], 0.f); v0[i] = a * a; v1[i] = b * b; }
                    u32x4 w; w.x = pkbf(v0[0], v0[1]); w.y = pkbf(v0[2], v0[3]); w.z = pkbf(v1[0], v1[1]); w.w = pkbf(v1[2], v1[3]);
                    *(u32x4*)(rowp + bj * 128) = w; } }
    }
};
struct SplitOrder {
    pg8::StaticOrder lat; int S, ntc, nr;
    __device__ void init(int N, int K, int S_, int G_, int c_, bool rev = false) { lat.init(MLAT, N, G_, c_); S = S_; ntc = S_ ? K / 64 / S_ : 0; nr = (rev && lat.nwg % G_ == 0) ? lat.nwg / G_ : 0; }
    __device__ bool next(int i, pg8::Unit& u) const {
        if (nr > 0 && i < nr) return lat.next(nr - 1 - i, u);
        if (lat.next(i, u)) return true;
        const int j = i * lat.G + lat.c - lat.nwg; if (j >= 16 * S) return false;
        const int tile = j / S, ch = j - tile * S; u.pm = 128 + (tile >> 2); u.pn = tile & 3; u.k0 = ch * ntc * 64; u.nt = ntc; return true;
    }
    __device__ __forceinline__ void a_ready(const pg8::Unit&) const {}
    __device__ __forceinline__ void done(const pg8::Unit&) const {}
};
struct EpiRes {
    static constexpr bool PERM = true, AFTER_DRAIN = false;
    const void* base_lat; const float* base_ctx; void* out_lat; float* out_ctx; const float* gate; float* part; int base_f32, out_f32;
    __device__ __forceinline__ void operator()(const f32x4 (&acc)[2][2][4][2], const pg8::Unit& u, int wr, int wc, int fr, int fq) const {
        const bool isctx = u.pm >= 128; const int s = isctx ? 4 : (u.pm >> 5);
        const int col0 = u.pn * 256 + wc * 32 + 8 * fq;
        const float* gp = gate + s * 6144 + col0;
        int row0 = (isctx ? u.pm - 128 : u.pm) * 256 + wr * 64 + fr; asm volatile("" : "+v"(row0));
        f32x4 g[2][2];
#pragma unroll
        for (int bj = 0; bj < 2; ++bj) { g[bj][0] = *(const f32x4*)(gp + bj * 128); g[bj][1] = *(const f32x4*)(gp + bj * 128 + 4); }
        if (u.nt != 0) {
            float* pp = part + (size_t)(u.k0 / (u.nt * 64)) * MCTX * DM;
#pragma unroll
            for (int ai = 0; ai < 2; ++ai)
#pragma unroll
                for (int m = 0; m < 4; ++m) { float* o = pp + (size_t)(row0 + ai * 128 + m * 16) * DM + col0;
#pragma unroll
                    for (int bj = 0; bj < 2; ++bj)
#pragma unroll
                        for (int n = 0; n < 2; ++n) *(f32x4*)(o + bj * 128 + 4 * n) = g[bj][n] * acc[ai][bj][m][n]; }
            return;
        }
        const bool bf = isctx || base_f32, of = isctx || out_f32;
        const float* bpf = isctx ? base_ctx : (const float*)base_lat; float* opf = isctx ? out_ctx : (float*)out_lat;
        const bf16_t* bph = (const bf16_t*)base_lat; bf16_t* oph = (bf16_t*)out_lat;
#pragma unroll
        for (int ai = 0; ai < 2; ++ai)
#pragma unroll
            for (int m = 0; m < 4; ++m) { const size_t off = (size_t)(row0 + ai * 128 + m * 16) * DM + col0;
#pragma unroll
                for (int bj = 0; bj < 2; ++bj) {
                    f32x4 b0, b1;
                    if (bf) { b0 = *(const f32x4*)(bpf + off + bj * 128); b1 = *(const f32x4*)(bpf + off + bj * 128 + 4); }
                    else { const u32x4 w = *(const u32x4*)(bph + off + bj * 128);
                        b0 = (f32x4){__uint_as_float(w.x << 16), __uint_as_float(w.x & 0xffff0000u), __uint_as_float(w.y << 16), __uint_as_float(w.y & 0xffff0000u)};
                        b1 = (f32x4){__uint_as_float(w.z << 16), __uint_as_float(w.z & 0xffff0000u), __uint_as_float(w.w << 16), __uint_as_float(w.w & 0xffff0000u)}; }
                    const f32x4 o0 = b0 + g[bj][0] * acc[ai][bj][m][0], o1 = b1 + g[bj][1] * acc[ai][bj][m][1];
                    if (of) { *(f32x4*)(opf + off + bj * 128) = o0; *(f32x4*)(opf + off + bj * 128 + 4) = o1; }
                    else { u32x4 w; w.x = pkbf(o0[0], o0[1]); w.y = pkbf(o0[2], o0[3]); w.z = pkbf(o1[0], o1[1]); w.w = pkbf(o1[2], o1[3]); *(u32x4*)(oph + off + bj * 128) = w; } } }
    }
};
struct EpiQKV {
    static constexpr bool PERM = true, AFTER_DRAIN = false;
    bf16_t* Q; size_t kstride; int kvpitch; int nk_tiles;
    const float* gains; const float* rope;
    __device__ __forceinline__ void operator()(const f32x4 (&acc)[2][2][4][2], const pg8::Unit& u, int wr, int wc, int fr, int fq) const {
        const int pn = u.pn; const int kind = pn < 4 ? 0 : (pn < 4 + nk_tiles ? 1 : 2);
        const int hd = (kind == 0 ? pn : (kind == 1 ? pn - 4 : pn - 4 - nk_tiles)) * 4 + wc;
        bf16_t* dst = Q + (size_t)kind * kstride + hd * 64 + 8 * fq; const int pitch = kind == 0 ? DM : kvpitch;
        const float* gp = gains + (kind & 1) * 64 + 8 * fq;
        const bool dorope = (rope != nullptr) && kind < 2 && u.pm < 128;
        const float* rp = rope + 8 * (fq & 1);
        int rbase = u.pm * 256 + wr * 64 + fr; asm volatile("" : "+v"(rbase));
        const int paddr = ((fr + 16 * fq) ^ 32) << 2;
#pragma unroll
        for (int ai = 0; ai < 2; ++ai)
#pragma unroll
            for (int m = 0; m < 4; ++m) {
                const int row = rbase + ai * 128 + m * 16;
                float rs = 1.0f;
                if (kind < 2) {
                    float ss = 0.f;
#pragma unroll
                    for (int bj = 0; bj < 2; ++bj)
#pragma unroll
                        for (int n = 0; n < 2; ++n) { const f32x4 x = acc[ai][bj][m][n]; ss += (x[0] * x[0] + x[1] * x[1]) + (x[2] * x[2] + x[3] * x[3]); }
                    ss = xsum4(ss);
                    rs = rsqrtf(ss * (1.0f / 64.0f) + EPS);
                }
                const int t = row & (SEQ - 1);
#pragma unroll
                for (int bj = 0; bj < 2; ++bj) {
                    f32x4 v0 = acc[ai][bj][m][0], v1 = acc[ai][bj][m][1];
                    if (kind < 2) {
                        v0 = v0 * rs * *(const f32x4*)(gp + 32 * bj); v1 = v1 * rs * *(const f32x4*)(gp + 32 * bj + 4);
                        if (dorope) {
                            const int pos = bj ? (t & 63) : (t >> 6);
                            const f32x4 c0 = *(const f32x4*)(rp + pos * 16), c1 = *(const f32x4*)(rp + pos * 16 + 4);
                            const f32x4 s0 = *(const f32x4*)(rp + 2048 + pos * 16), s1 = *(const f32x4*)(rp + 2048 + pos * 16 + 4);
                            f32x4 o0, o1;
#pragma unroll
                            for (int i = 0; i < 4; ++i) { const float p0 = __uint_as_float((unsigned)__builtin_amdgcn_ds_bpermute(paddr, (int)__float_as_uint(v0[i]))) * s0[i], p1 = __uint_as_float((unsigned)__builtin_amdgcn_ds_bpermute(paddr, (int)__float_as_uint(v1[i]))) * s1[i];
                                o0[i] = v0[i] * c0[i] + (fq >= 2 ? p0 : -p0); o1[i] = v1[i] * c1[i] + (fq >= 2 ? p1 : -p1); }
                            v0 = o0; v1 = o1;
                        }
                    }
                    u32x4 w; w.x = pkbf(v0[0], v0[1]); w.y = pkbf(v0[2], v0[3]); w.z = pkbf(v1[0], v1[1]); w.w = pkbf(v1[2], v1[3]);
                    *(u32x4*)(dst + (size_t)row * pitch + 32 * bj) = w;
                }
                asm volatile("" ::: "memory");
            }
    }
};

namespace att {
#define DMA_SYNC() do { asm volatile("s_waitcnt vmcnt(0)" ::: "memory"); __syncthreads(); } while (0)
__device__ __forceinline__ float red_max4(float v) {
    auto a = __builtin_amdgcn_permlane16_swap(__float_as_uint(v), __float_as_uint(v), false, false);
    v = fmaxf(__uint_as_float(a[0]), __uint_as_float(a[1]));
    auto b = __builtin_amdgcn_permlane32_swap(__float_as_uint(v), __float_as_uint(v), false, false);
    return fmaxf(__uint_as_float(b[0]), __uint_as_float(b[1]));
}
__device__ __forceinline__ float red_sum4(float v) {
    auto a = __builtin_amdgcn_permlane16_swap(__float_as_uint(v), __float_as_uint(v), false, false);
    v = __uint_as_float(a[0]) + __uint_as_float(a[1]);
    auto b = __builtin_amdgcn_permlane32_swap(__float_as_uint(v), __float_as_uint(v), false, false);
    return __uint_as_float(b[0]) + __uint_as_float(b[1]);
}
typedef short v4i16_t __attribute__((ext_vector_type(4)));
__device__ __forceinline__ s16x4 vtr(const LAS unsigned char* p) { return __builtin_bit_cast(s16x4, __builtin_amdgcn_ds_read_tr16_b64_v4i16((LAS v4i16_t*)p)); }
__device__ __forceinline__ bf16x8 cat8(s16x4 a, s16x4 b) { return (bf16x8){a[0], a[1], a[2], a[3], b[0], b[1], b[2], b[3]}; }
__device__ __forceinline__ bf16x8 pack8(const f32x4& a, const f32x4& b) { u32x4 w; w.x = pkbf(a[0], a[1]); w.y = pkbf(a[2], a[3]); w.z = pkbf(b[0], b[1]); w.w = pkbf(b[2], b[3]); return __builtin_bit_cast(bf16x8, w); }

struct DmaLane { unsigned koff, voff; };
__device__ __forceinline__ DmaLane dma_lane(int pitch, int col0, int w, int lane) {
    const int key = 8 * w + (lane >> 3), slot = lane & 7;
    const int c8k = slot ^ (key & 7), c8v = (((slot >> 1) ^ ((key >> 1) & 3)) << 1) | (slot & 1);
    DmaLane d; d.koff = (unsigned)((key * pitch + col0 + c8k * 8) * 2); d.voff = (unsigned)((key * pitch + col0 + c8v * 8) * 2); return d;
}
__device__ __forceinline__ void glds16(const unsigned char* sbase, unsigned voff, unsigned lds_dst) { unsigned keep;
    asm volatile("s_mov_b32 %0, m0\n\ts_mov_b32 m0, %3\n\ts_nop 0\n\tglobal_load_lds_dwordx4 %1, %2\n\ts_mov_b32 m0, %0" : "=&s"(keep) : "v"(voff), "s"(sbase), "s"(lds_dst) : "memory"); }
template <int NHT> __device__ __forceinline__ void dma_tile(LAS unsigned char* buf, const bf16_t* Kg, const bf16_t* Vg, size_t row0, int pitch, const DmaLane& d, int w) {
    const unsigned char* kb = (const unsigned char*)Kg + row0 * (size_t)pitch * 2; const unsigned char* vb = (const unsigned char*)Vg + row0 * (size_t)pitch * 2;
    const unsigned l0 = (unsigned)__builtin_amdgcn_readfirstlane((int)(unsigned)(uintptr_t)buf + w * 1024);
#pragma unroll
    for (int hh = 0; hh < NHT; ++hh) {
        glds16(kb, d.koff + hh * 128, l0 + hh * 8192);
        glds16(vb, d.voff + hh * 128, l0 + NHT * 8192 + hh * 8192); }
}

template <int NB16> __device__ __forceinline__ float exp_step(f32x4 (&S)[NB16]) {
    float sum = 0.f;
#pragma unroll
    for (int k = 0; k < NB16; ++k)
#pragma unroll
        for (int i = 0; i < 4; ++i) { S[k][i] = __builtin_amdgcn_exp2f(S[k][i]); sum += S[k][i]; }
    return sum;
}

template <int MASK, int GPB, int SB = 1> __device__ __forceinline__ void full_tile(f32x4 (&O)[4][4], float (&ls)[4], const bf16x8 (&qf)[4][2], float negb,
                                                            const LAS unsigned char* Kt, const LAS unsigned char* Vt, int lane, int rel0) {
    const int l15 = lane & 15, g = lane >> 4, q4 = l15 >> 2;
    const LAS unsigned char* kb0 = Kt + l15 * 128;
    const int kx0 = ((g) ^ (l15 & 7)) << 4, kx1 = ((4 + g) ^ (l15 & 7)) << 4;
    const LAS unsigned char* vrow = Vt + (4 * g + q4) * 128 + (lane & 3) * 8;
    const int swz = (2 * (g & 1) + (q4 >> 1)) & 3;
    const f32x4 cinit = (f32x4){negb, negb, negb, negb};
#pragma unroll
    for (int gh = 0; gh < 4 / GPB; ++gh) {
        f32x4 S[GPB][4];
#pragma unroll
        for (int kb = 0; kb < 4; ++kb) {
            const bf16x8 kf0 = *(const LAS bf16x8*)(kb0 + (16 * kb) * 128 + kx0), kf1 = *(const LAS bf16x8*)(kb0 + (16 * kb) * 128 + kx1);
#pragma unroll
            for (int gi = 0; gi < GPB; ++gi) { S[gi][kb] = __builtin_amdgcn_mfma_f32_16x16x32_bf16(kf0, qf[GPB * gh + gi][0], cinit, 0, 0, 0);
                S[gi][kb] = __builtin_amdgcn_mfma_f32_16x16x32_bf16(kf1, qf[GPB * gh + gi][1], S[gi][kb], 0, 0, 0); } }
        bf16x8 pf[GPB][2];
#pragma unroll
        for (int gi = 0; gi < GPB; ++gi) {
            if (MASK) {
#pragma unroll
                for (int kb = 0; kb < 4; ++kb)
#pragma unroll
                    for (int i = 0; i < 4; ++i) { const int rel = rel0 + 16 * kb + 4 * g + i; S[gi][kb][i] = ((unsigned)(rel + 128) > 256u) ? NEGBIG : S[gi][kb][i]; }
            }
            ls[GPB * gh + gi] += exp_step<4>(S[gi]);
            pf[gi][0] = pack8(S[gi][0], S[gi][1]); pf[gi][1] = pack8(S[gi][2], S[gi][3]);
        }
#pragma unroll
        for (int kc = 0; kc < 2; ++kc)
#pragma unroll
            for (int db = 0; db < 4; ++db) {
                const LAS unsigned char* va = vrow + ((db ^ swz) << 5) + (32 * kc) * 128;
                const bf16x8 vf = cat8(vtr(va), vtr(va + 16 * 128));
#pragma unroll
                for (int gi = 0; gi < GPB; ++gi) O[GPB * gh + gi][db] = __builtin_amdgcn_mfma_f32_16x16x32_bf16(vf, pf[gi][kc], O[GPB * gh + gi][db], 0, 0, 0);
            }
        if (SB == 1) __builtin_amdgcn_sched_barrier(0); else if (SB == 2) __builtin_amdgcn_sched_barrier(0x108);
    }
}

__device__ __forceinline__ void na_local_tile(f32x4 (&O)[4][4], float (&ls)[4], const bf16x8 (&qf)[4][2], float negb,
                                              const LAS unsigned char* Kt, const LAS unsigned char* Vt, int lane, const LAS float* bias_row, bool rowvalid) {
    const int l15 = lane & 15, g = lane >> 4, q4 = l15 >> 2;
    const LAS unsigned char* kb0 = Kt + l15 * 128;
    const int kx0 = ((g) ^ (l15 & 7)) << 4, kx1 = ((4 + g) ^ (l15 & 7)) << 4;
    const LAS unsigned char* vrow = Vt + (4 * g + q4) * 128 + (lane & 3) * 8;
    const int swz = (2 * (g & 1) + (q4 >> 1)) & 3;
#pragma unroll
    for (int grp = 0; grp < 4; ++grp) {
        const int kwin = grp == 0 ? 0 : (grp == 1 ? 8 : (grp == 2 ? 24 : 32));
        f32x4 S[2];
#pragma unroll
        for (int k2 = 0; k2 < 2; ++k2) {
            const bf16x8 kf0 = *(const LAS bf16x8*)(kb0 + (kwin + 16 * k2) * 128 + kx0), kf1 = *(const LAS bf16x8*)(kb0 + (kwin + 16 * k2) * 128 + kx1);
            S[k2] = __builtin_amdgcn_mfma_f32_16x16x32_bf16(kf0, qf[grp][0], (f32x4){negb, negb, negb, negb}, 0, 0, 0);
            S[k2] = __builtin_amdgcn_mfma_f32_16x16x32_bf16(kf1, qf[grp][1], S[k2], 0, 0, 0); }
        const int c = 16 * grp + l15; const int c0 = rowvalid ? min(max(c - 8, 0), 48) : 4096;
        const LAS float* bl = bias_row + (15 - c + 4 * g);
#pragma unroll
        for (int k2 = 0; k2 < 2; ++k2)
#pragma unroll
            for (int i = 0; i < 4; ++i) { const int kc = kwin + 16 * k2 + 4 * g + i; const float bias = bl[kwin + 16 * k2 + i];
                S[k2][i] = ((unsigned)(kc - c0) < 16u) ? S[k2][i] + bias : NEGBIG; }
        ls[grp] += exp_step<2>(S);
        const bf16x8 pf = pack8(S[0], S[1]);
#pragma unroll
        for (int db = 0; db < 4; ++db) {
            const LAS unsigned char* va = vrow + ((db ^ swz) << 5) + kwin * 128;
            const bf16x8 vf = cat8(vtr(va), vtr(va + 16 * 128));
            O[grp][db] = __builtin_amdgcn_mfma_f32_16x16x32_bf16(vf, pf, O[grp][db], 0, 0, 0);
        }
        __builtin_amdgcn_sched_barrier(0x108);
    }
}

__device__ __forceinline__ void store_group(const f32x4 (&Og)[4], float inv, bf16_t* orow, int g) {
#pragma unroll
    for (int db = 0; db < 4; ++db) { u32x2 w; w.x = pkbf(Og[db][0] * inv, Og[db][1] * inv); w.y = pkbf(Og[db][2] * inv, Og[db][3] * inv);
        *(u32x2*)(orow + 16 * db + 4 * g) = w; }
}

template <int NI> __device__ __forceinline__ void ring_wait() { asm volatile("s_waitcnt vmcnt(%0)" :: "n"(2 * NI) : "memory"); __syncthreads(); }
__device__ __forceinline__ void drain_wait() { asm volatile("s_waitcnt vmcnt(0)" ::: "memory"); __syncthreads(); }
__device__ __forceinline__ int item_of(int it, int nmain, int ntotal) {
    const int bid = blockIdx.x, G = gridDim.x;
    if (G == 256 && nmain == 1024) { if (it < 4) return 128 * (bid & 7) + 32 * it + (bid >> 3); const int e = nmain + (it - 4) * 256 + bid; return e < ntotal ? e : -1; }
    const int e = bid + it * G; return e < ntotal ? e : -1;
}

constexpr int NA_BUF = 32768;
constexpr int NA_TAB = 4 * NA_BUF;
constexpr int NA_ITEMS_LAT = NB * 8 * 32, NA_ITEMS = NA_ITEMS_LAT + NB * 8;
__device__ __forceinline__ void na_phase(LAS unsigned char* lds, const bf16_t* Q, const bf16_t* K, const bf16_t* V, bf16_t* Ob, const float* rpb, float negb) {
    int tid_ = threadIdx.x; asm volatile("" : "+v"(tid_));
    const int tid = tid_, lane = tid & 63, w = __builtin_amdgcn_readfirstlane(tid >> 6), l15 = lane & 15, g = lane >> 4;
    LAS float* tab = (LAS float*)(lds + NA_TAB);
    for (int it = 0;; ++it) {
        const int item = item_of(it, NA_ITEMS_LAT, NA_ITEMS); if (item < 0) break;
        const bool isctx = item >= NA_ITEMS_LAT;
        int b, hp, rq;
        if (!isctx) { b = item >> 8; hp = (item >> 5) & 7; rq = item & 31; } else { const int j = item - NA_ITEMS_LAT; b = j >> 3; hp = j & 7; rq = 0; }
        const int hh = w >> 2, head = 2 * hp + hh;
        const size_t ctx0 = (size_t)(MLAT + b * NCTX), lat0 = (size_t)(b * SEQ);
        const int kr_lo = min(max(4 * rq - 4, 0), 120), kr_hi = min(max(4 * rq - 1, 0), 120) + 8;
        const int NT = 4 + (isctx ? 0 : kr_hi - kr_lo);
        const DmaLane dl = dma_lane(DM, hp * 128, w, lane);
#define NA_ROW0(t) ((t) < 4 ? ctx0 + 64 * (t) : ((t) < NT ? lat0 + (size_t)(kr_lo + (t) - 4) * 64 : ctx0))
        dma_tile<2>(lds, K, V, NA_ROW0(0), DM, dl, w);
        dma_tile<2>(lds + NA_BUF, K, V, NA_ROW0(1), DM, dl, w);
        dma_tile<2>(lds + 2 * NA_BUF, K, V, NA_ROW0(2), DM, dl, w);
        for (int i = tid; i < 2 * 465; i += 512) { const int h2 = i / 465, e = i - h2 * 465; tab[h2 * 512 + e] = rpb[(2 * hp + h2) * 465 + e] * LOG2E; }
        const int r = 4 * rq + (w & 3);
        const size_t qrow0 = isctx ? (size_t)(MLAT + b * NCTX + (w & 3) * 64) : (size_t)(b * SEQ + r * 64);
        bf16x8 qf[4][2];
#pragma unroll
        for (int grp = 0; grp < 4; ++grp)
#pragma unroll
            for (int ds = 0; ds < 2; ++ds) qf[grp][ds] = *(const bf16x8*)(Q + (qrow0 + 16 * grp + l15) * DM + head * 64 + 32 * ds + 8 * g);
        f32x4 O[4][4]; float ls[4];
#pragma unroll
        for (int grp = 0; grp < 4; ++grp) { ls[grp] = 0.f;
#pragma unroll
            for (int db = 0; db < 4; ++db) O[grp][db] = (f32x4){0.f, 0.f, 0.f, 0.f}; }
        const int r0w = min(max(r - 4, 0), 120);
        drain_wait();
        for (int t = 0; t < 4; ++t) {
            dma_tile<2>(lds + ((t + 3) & 3) * NA_BUF, K, V, NA_ROW0(t + 3), DM, dl, w);
            const LAS unsigned char* buf = lds + (t & 3) * NA_BUF;
            full_tile<0, 1, 2>(O, ls, qf, negb, buf + hh * 8192, buf + 2 * 8192 + hh * 8192, lane, 0);
            ring_wait<4>();
        }
        for (int t = 4; t < NT; ++t) {
            dma_tile<2>(lds + ((t + 3) & 3) * NA_BUF, K, V, NA_ROW0(t + 3), DM, dl, w);
            const LAS unsigned char* buf = lds + (t & 3) * NA_BUF;
            const int kr = kr_lo + t - 4; const bool rv = kr >= r0w && kr < r0w + 8;
            if (rv) na_local_tile(O, ls, qf, negb, buf + hh * 8192, buf + 2 * 8192 + hh * 8192, lane, tab + hh * 512 + (kr - r + 7) * 31, true);
            ring_wait<4>();
        }
#undef NA_ROW0
#pragma unroll
        for (int grp = 0; grp < 4; ++grp) { const float lt = red_sum4(ls[grp]); store_group(O[grp], __builtin_amdgcn_rcpf(lt), Ob + (qrow0 + 16 * grp + l15) * DM + head * 64, g); }
    }
}

constexpr int SW_BUF = 16384;
constexpr int SW_ITEMS = NB * 4 * 64;
__device__ __forceinline__ void swa_phase(LAS unsigned char* lds, const bf16_t* Q, const bf16_t* K, const bf16_t* V, bf16_t* Ob, const float* sink, float negb) {
    int tid_ = threadIdx.x; asm volatile("" : "+v"(tid_));
    const int tid = tid_, lane = tid & 63, w = __builtin_amdgcn_readfirstlane(tid >> 6), l15 = lane & 15, g = lane >> 4;
    for (int it = 0;; ++it) {
        const int item = item_of(it, SW_ITEMS, SW_ITEMS); if (item < 0) break;
        const int b = item >> 8, kvh = (item >> 6) & 3, tb = item & 63;
        const size_t ctx0 = (size_t)(MLAT + b * NCTX), lat0 = (size_t)(b * SEQ);
        const int i_lo = tb == 0 ? 2 : 0, i_hi = tb == 63 ? 4 : 6;
        const int NT = 4 + (i_hi - i_lo);
        const DmaLane dl = dma_lane(256, kvh * 64, w, lane);
#define SW_ROW0(t) ((t) < 4 ? ctx0 + 64 * (t) : ((t) < NT ? lat0 + (size_t)(128 * tb - 128 + 64 * (i_lo + (t) - 4)) : ctx0))
        dma_tile<1>(lds, K, V, SW_ROW0(0), 256, dl, w);
        dma_tile<1>(lds + SW_BUF, K, V, SW_ROW0(1), 256, dl, w);
        dma_tile<1>(lds + 2 * SW_BUF, K, V, SW_ROW0(2), 256, dl, w);
        const int tq = 128 * tb + 16 * w;
        const size_t qrow = (size_t)(b * SEQ + tq + l15);
        bf16x8 qf[4][2];
#pragma unroll
        for (int grp = 0; grp < 4; ++grp)
#pragma unroll
            for (int ds = 0; ds < 2; ++ds) qf[grp][ds] = *(const bf16x8*)(Q + qrow * DM + (4 * kvh + grp) * 64 + 32 * ds + 8 * g);
        f32x4 O[4][4]; float ls[4];
#pragma unroll
        for (int grp = 0; grp < 4; ++grp) { ls[grp] = 0.f;
#pragma unroll
            for (int db = 0; db < 4; ++db) O[grp][db] = (f32x4){0.f, 0.f, 0.f, 0.f}; }
        drain_wait();
        for (int t = 0; t < 4; ++t) {
            dma_tile<1>(lds + ((t + 3) & 3) * SW_BUF, K, V, SW_ROW0(t + 3), 256, dl, w);
            const LAS unsigned char* buf = lds + (t & 3) * SW_BUF;
            full_tile<0, 2, 2>(O, ls, qf, negb, buf, buf + 8192, lane, 0);
            ring_wait<2>();
        }
        for (int t = 4; t < NT; ++t) {
            dma_tile<1>(lds + ((t + 3) & 3) * SW_BUF, K, V, SW_ROW0(t + 3), 256, dl, w);
            const LAS unsigned char* buf = lds + (t & 3) * SW_BUF;
            const int start = 128 * tb - 128 + 64 * (i_lo + t - 4);
            if (start + 63 >= tq - 128 && start <= tq + 15 + 128)
                full_tile<1, 2, 2>(O, ls, qf, negb, buf, buf + 8192, lane, start - (tq + l15));
            ring_wait<2>();
        }
#undef SW_ROW0
#pragma unroll
        for (int grp = 0; grp < 4; ++grp) { const float lt = red_sum4(ls[grp]) + __builtin_amdgcn_exp2f(sink[4 * kvh + grp] * LOG2E + negb);
            store_group(O[grp], __builtin_amdgcn_rcpf(lt), Ob + qrow * DM + (4 * kvh + grp) * 64, g); }
    }
}
}

__device__ __forceinline__ float wave_sum(float v) {
#pragma unroll
    for (int o = 1; o < 64; o <<= 1) v += __shfl_xor(v, o);
    return v;
}
__device__ __forceinline__ void transpose_item(const float* W, int K, int N, bf16_t* WT, bool perm, LAS float* scr, int item, int lane) {
    const int nblk = N / 32, kb = item / nblk, nb = item % nblk, k0 = 64 * kb, n0 = 32 * nb;
    const int r0 = perm ? ((n0 & ~255) + 128 * ((n0 >> 5) & 1) + 32 * ((n0 >> 6) & 3)) : n0;
#pragma unroll
    for (int i = 0; i < 32; ++i) { const int kk = 2 * i + (lane >> 5); scr[kk * 33 + (lane & 31)] = W[(size_t)(k0 + kk) * N + n0 + (lane & 31)]; }
    asm volatile("s_waitcnt lgkmcnt(0)" ::: "memory");
    const int c = lane & 7;
#pragma unroll
    for (int j = 0; j < 4; ++j) { const int n = (lane >> 3) + 8 * j; const LAS float* s = scr + (8 * c) * 33 + n;
        u32x4 o; o.x = pkbf(s[0 * 33], s[1 * 33]); o.y = pkbf(s[2 * 33], s[3 * 33]); o.z = pkbf(s[4 * 33], s[5 * 33]); o.w = pkbf(s[6 * 33], s[7 * 33]);
        *(u32x4*)(WT + (size_t)(r0 + n) * K + k0 + 8 * c) = o; }
    asm volatile("s_waitcnt lgkmcnt(0)" ::: "memory");
}

struct Args {
    const float *x, *c, *ctx, *c_ctx, *ada_w, *ada_b, *g_mix, *g_mlp, *mlp_w1, *mlp_w2, *na_wqkv, *na_q_gain, *na_k_gain, *na_rpb, *na_wo,
                *swa_wqkv, *swa_q_gain, *swa_k_gain, *swa_sink, *swa_wo;
    float* out; unsigned char* ws;
};

__device__ __forceinline__ void prologue_phase(const Args& a, LAS unsigned char* lds) {
    const int tid = threadIdx.x, lane = tid & 63, w = __builtin_amdgcn_readfirstlane(tid >> 6);
    float* mods = (float*)(a.ws + WS_MODS);
    if (blockIdx.x < 96) {
        const int l = blockIdx.x / 48, cgp = blockIdx.x % 48; const int j = 128 * cgp + 2 * lane;
        LAS float* sil = (LAS float*)(lds + 32768);
        for (int i = tid; i < 5 * DM; i += 512) { const float cv = i < 4 * DM ? a.c[i] : a.c_ctx[i - 4 * DM]; sil[i] = cv / (1.0f + __expf(-cv)); }
        __syncthreads();
        float acc[5][2];
#pragma unroll
        for (int s = 0; s < 5; ++s) { acc[s][0] = 0.f; acc[s][1] = 0.f; }
        const float* wp = a.ada_w + ((size_t)l * DM + 128 * w) * 6144 + j;
#pragma unroll 8
        for (int kk = 0; kk < 128; ++kk) { const int k = 128 * w + kk; const f32x2_t wv = *(const f32x2_t*)(wp + (size_t)kk * 6144);
#pragma unroll
            for (int s = 0; s < 5; ++s) { const float sv = sil[s * DM + k]; acc[s][0] += sv * wv.x; acc[s][1] += sv * wv.y; } }
        LAS float* part = (LAS float*)lds;
#pragma unroll
        for (int s = 0; s < 5; ++s) { part[(w * 5 + s) * 128 + 2 * lane] = acc[s][0]; part[(w * 5 + s) * 128 + 2 * lane + 1] = acc[s][1]; }
        __syncthreads();
        for (int idx = tid; idx < 640; idx += 512) { const int s = idx >> 7, col = idx & 127; float t = 0.f;
#pragma unroll
            for (int ww = 0; ww < 8; ++ww) t += part[(ww * 5 + s) * 128 + col];
            mods[(l * 5 + s) * 6144 + 128 * cgp + col] = t + a.ada_b[l * 6144 + 128 * cgp + col]; }
        __syncthreads();
    } else if (blockIdx.x == 96) {
        float* rope = (float*)(a.ws + WS_ROPE);
        for (int idx = tid; idx < 2048; idx += 512) { const int pos = idx >> 4, f = idx & 15;
            const float inv = exp2f(-(float)f * (13.287712379549449f / 16.0f)); const float ang = (float)pos * inv;
            float xr = ang * 0.15915494309189535f; xr -= floorf(xr);
            rope[idx] = __builtin_amdgcn_cosf(xr); rope[2048 + idx] = __builtin_amdgcn_sinf(xr); }
        float* gains = (float*)(a.ws + WS_GAINS);
        if (tid < 256) { const int l = tid >> 7, k = (tid >> 6) & 1, d = tid & 63;
            const float* src = l == 0 ? (k == 0 ? a.na_q_gain : a.na_k_gain) : (k == 0 ? a.swa_q_gain : a.swa_k_gain);
            gains[tid] = src[d] * (k == 0 ? QSCALE : 1.0f); }
        if (tid == 0) *(Args*)(a.ws + WS_ARGS) = a;
        float mxb = -1e30f;
        for (int i = tid; i < NHEAD * 465; i += 512) mxb = fmaxf(mxb, a.na_rpb[i]);
#pragma unroll
        for (int o = 1; o < 64; o <<= 1) mxb = fmaxf(mxb, __shfl_xor(mxb, o));
        LAS float* red = (LAS float*)lds;
        if (lane == 0) red[w] = mxb;
        __syncthreads();
        if (w == 0) {
            float g0 = fabsf(a.na_q_gain[lane]), g1 = fabsf(a.na_k_gain[lane]), g2 = fabsf(a.swa_q_gain[lane]), g3 = fabsf(a.swa_k_gain[lane]);
#pragma unroll
            for (int o = 1; o < 64; o <<= 1) { g0 = fmaxf(g0, __shfl_xor(g0, o)); g1 = fmaxf(g1, __shfl_xor(g1, o)); g2 = fmaxf(g2, __shfl_xor(g2, o)); g3 = fmaxf(g3, __shfl_xor(g3, o)); }
            float mb = red[0];
#pragma unroll
            for (int i = 1; i < 8; ++i) mb = fmaxf(mb, red[i]);
            if (lane == 0) { float* bnd = (float*)(a.ws + WS_BND); bnd[0] = (8.0f * g0 * g1 + fmaxf(mb, 0.f)) * LOG2E; bnd[1] = 8.0f * g2 * g3 * LOG2E; }
        }
        __syncthreads();
    }
    LAS float* scr = (LAS float*)(lds + w * 16384);
    const int gw = blockIdx.x * 8 + w, ngw = gridDim.x * 8;
    constexpr int I_QKV0 = 16 * 96, I_WO = 16 * 32, I_QKV1 = 16 * 48, I_W1 = 16 * 128, I_W2 = 64 * 32;
    constexpr int NITEMS = I_QKV0 + 2 * I_WO + I_QKV1 + 2 * I_W1 + 2 * I_W2;
    constexpr int HCAP = 2; const int nfree = ((int)gridDim.x > 96 ? (int)gridDim.x - 96 : 0) * 8, pre = nfree * HCAP < NITEMS ? nfree * HCAP : 0;
    const int fw = ((int)blockIdx.x - 96) * 8 + w;
    for (int k = 0;; ++k) {
        int it;
        if (pre && k < HCAP) { if ((int)blockIdx.x < 96) continue; it = fw + k * nfree; }
        else { it = pre + gw + (k - (pre ? HCAP : 0)) * ngw; if (it >= NITEMS) break; }
        int r = it;
        if (r < I_QKV0) { transpose_item(a.na_wqkv, DM, 3072, (bf16_t*)(a.ws + WS_WQKV0), true, scr, r, lane); continue; } r -= I_QKV0;
        if (r < I_WO) { transpose_item(a.na_wo, DM, DM, (bf16_t*)(a.ws + WS_WO0), false, scr, r, lane); continue; } r -= I_WO;
        if (r < I_QKV1) { transpose_item(a.swa_wqkv, DM, 1536, (bf16_t*)(a.ws + WS_WQKV1), true, scr, r, lane); continue; } r -= I_QKV1;
        if (r < I_WO) { transpose_item(a.swa_wo, DM, DM, (bf16_t*)(a.ws + WS_WO1), false, scr, r, lane); continue; } r -= I_WO;
        if (r < 2 * I_W1) { const int l = r / I_W1; transpose_item(a.mlp_w1 + (size_t)l * DM * DFF, DM, DFF, (bf16_t*)(a.ws + WS_W1) + (size_t)l * DM * DFF, false, scr, r % I_W1, lane); continue; } r -= 2 * I_W1;
        { const int l = r / I_W2; transpose_item(a.mlp_w2 + (size_t)l * DM * DFF, DFF, DM, (bf16_t*)(a.ws + WS_W2) + (size_t)l * DM * DFF, false, scr, r % I_W2, lane); }
    }
}

__device__ __forceinline__ void norm_phase(const void* src_lat, int lat_f32, const float* src_ctx, int nrows, const float* gvec, const float* mods_l, int sh_off, int sc_off, bf16_t* U, const float* part, int nparts, float* ctx_out) {
    int tid_ = threadIdx.x; asm volatile("" : "+v"(tid_));
    const int lane = tid_ & 63, w = __builtin_amdgcn_readfirstlane(tid_ >> 6);
    const int gw = blockIdx.x * 8 + w, ngw = gridDim.x * 8;

    f32x4 gv[4];
#pragma unroll
    for (int j = 0; j < 4; ++j) gv[j] = *(const f32x4*)(gvec + 4 * lane + 256 * j);
    for (int row = gw; row < nrows; row += ngw) {
        const int s = row < MLAT ? (row >> 13) : 4;
        f32x4 v[4]; float ss = 0.f;
        if (row < MLAT && !lat_f32) { const bf16_t* src = (const bf16_t*)src_lat + (size_t)row * DM + 4 * lane;
#pragma unroll
            for (int j = 0; j < 4; ++j) { const u32x2 w = *(const u32x2*)(src + 256 * j);
                v[j] = (f32x4){__uint_as_float(w.x << 16), __uint_as_float(w.x & 0xffff0000u), __uint_as_float(w.y << 16), __uint_as_float(w.y & 0xffff0000u)}; } }
        else { const float* src = row < MLAT ? (const float*)src_lat + (size_t)row * DM : src_ctx + (size_t)(row - MLAT) * DM;
#pragma unroll
            for (int j = 0; j < 4; ++j) v[j] = *(const f32x4*)(src + 4 * lane + 256 * j); }
#pragma unroll
        for (int j = 0; j < 4; ++j) { ss += (v[j][0] * v[j][0] + v[j][1] * v[j][1]) + (v[j][2] * v[j][2] + v[j][3] * v[j][3]); }
        if (nparts != 0 && row >= MLAT) {
            for (int ch = 0; ch < nparts; ch += 4) {
                f32x4 pv[4][4];
#pragma unroll
                for (int c4 = 0; c4 < 4; ++c4) { const float* pr = part + ((size_t)(ch + c4) * MCTX + (row - MLAT)) * DM + 4 * lane;
#pragma unroll
                    for (int j = 0; j < 4; ++j) pv[c4][j] = *(const f32x4*)(pr + 256 * j); }
#pragma unroll
                for (int c4 = 0; c4 < 4; ++c4)
#pragma unroll
                    for (int j = 0; j < 4; ++j) v[j] = v[j] + pv[c4][j]; }
            ss = 0.f;
#pragma unroll
            for (int j = 0; j < 4; ++j) { *(f32x4*)(ctx_out + (size_t)(row - MLAT) * DM + 4 * lane + 256 * j) = v[j]; ss += (v[j][0] * v[j][0] + v[j][1] * v[j][1]) + (v[j][2] * v[j][2] + v[j][3] * v[j][3]); }
        }
        const float rs = rsqrtf(wave_sum64(ss) * (1.0f / DM) + EPS);
        const float* shp = mods_l + s * 6144 + sh_off + 4 * lane; const float* scp = mods_l + s * 6144 + sc_off + 4 * lane;
        bf16_t* up = U + (size_t)row * DM + 4 * lane;
#pragma unroll
        for (int j = 0; j < 4; ++j) { const f32x4 sh = *(const f32x4*)(shp + 256 * j), sc = *(const f32x4*)(scp + 256 * j);
            const f32x4 y = v[j] * rs * gv[j] * (sc + 1.0f) + sh;
            u32x2 o; o.x = pkbf(y[0], y[1]); o.y = pkbf(y[2], y[3]); *(u32x2*)(up + 256 * j) = o; }
    }
}

#define XB_TMO      128
#define XB_XCNT(j)  (256  + 64 * (j))
#define XB_XSUB(j)  (1280 + 64 * (j))
#define XB_XGEN(j)  (2304 + 64 * (j))
#define XB_TOP      3328
#define XB_TOPGEN   3392
#define XCD_BAR_WORDS 3456
#define XB_SPIN_CAP (1u << 18)

__device__ __forceinline__ unsigned xb_ld(unsigned* p)              { return __hip_atomic_load(p, __ATOMIC_RELAXED, __HIP_MEMORY_SCOPE_AGENT); }
__device__ __forceinline__ unsigned xb_add(unsigned* p, unsigned v) { return __hip_atomic_fetch_add(p, v, __ATOMIC_RELAXED, __HIP_MEMORY_SCOPE_AGENT); }
__device__ __forceinline__ unsigned xb_xcc_id() { return (unsigned)__builtin_amdgcn_s_getreg((3 << 11) | 20) & 0xFu; }
#define XB_SPIN(cond, bar) do { unsigned _sp = 0; while (cond) { __builtin_amdgcn_s_sleep(1); \
    if ((++_sp & 255u) == 0u) { if (xb_ld(&(bar)[XB_TMO])) break; if (_sp > XB_SPIN_CAP) { atomicAdd(&(bar)[XB_TMO], 1u); break; } } } } while (0)

struct XcdBarrier {
    unsigned* bar; unsigned x;
    volatile LAS unsigned* st;
};

__device__ __forceinline__ XcdBarrier xcd_barrier_post(unsigned* bar, volatile LAS unsigned* st) {
    XcdBarrier b; b.bar = bar; b.x = xb_xcc_id(); b.st = st;
    if (threadIdx.x == 0) (void)xb_add(&bar[XB_XCNT(b.x)], 1u);
    return b;
}
__device__ __forceinline__ void xcd_barrier_complete(unsigned* bar, unsigned x, unsigned& nloc, unsigned& nx) {
    const unsigned G = gridDim.x * gridDim.y * gridDim.z;
    unsigned sum, cnt, mine, sp = 0u;
    for (;;) {
        sum = 0u; cnt = 0u; mine = 0u;
#pragma unroll
        for (unsigned j = 0; j < 16; ++j) { const unsigned c = xb_ld(&bar[XB_XCNT(j)]); sum += c; cnt += (c > 0u) ? 1u : 0u; mine = (j == x) ? c : mine; }
        if (sum == G) break;
        __builtin_amdgcn_s_sleep(1);
        if ((++sp & 255u) == 0u) { if (xb_ld(&bar[XB_TMO])) break; if (sp > XB_SPIN_CAP) { atomicAdd(&bar[XB_TMO], 1u); break; } }
    }
    nloc = mine > 0u ? mine : 1u; nx = cnt > 0u ? cnt : 1u;
}

__device__ __forceinline__ void xcd_barrier(const XcdBarrier& b) {
    asm volatile("s_waitcnt vmcnt(0)" ::: "memory");
    __syncthreads();
    if (threadIdx.x == 0) {
        unsigned* bar = b.bar;
        __builtin_amdgcn_s_waitcnt(0);
        unsigned nloc = b.st[0], nx = b.st[1];
        if (nloc == 0u) { xcd_barrier_complete(bar, b.x, nloc, nx); b.st[0] = nloc; b.st[1] = nx; }
        const unsigned old = xb_add(&bar[XB_XSUB(b.x)], 1u);
        const unsigned gen = old / nloc;
        if (old + 1u == (gen + 1u) * nloc) {
            __builtin_amdgcn_fence(__ATOMIC_RELEASE, "agent");
            asm volatile("s_waitcnt vmcnt(0)" ::: "memory");
            const unsigned og = xb_add(&bar[XB_TOP], 1u);
            const unsigned tg = og / nx;
            if (og + 1u == (tg + 1u) * nx) xb_add(&bar[XB_TOPGEN], 1u);
            else XB_SPIN(xb_ld(&bar[XB_TOPGEN]) == tg, bar);
            __builtin_amdgcn_fence(__ATOMIC_ACQUIRE, "agent");
            xb_add(&bar[XB_XGEN(b.x)], 1u);
            asm volatile("s_waitcnt vmcnt(0)" ::: "memory");
        } else {
            XB_SPIN(xb_ld(&bar[XB_XGEN(b.x)]) == gen, bar);
            __builtin_amdgcn_fence(__ATOMIC_ACQUIRE, "agent");
            asm volatile("s_waitcnt vmcnt(0)" ::: "memory");
        }
    }
    __syncthreads();
}

constexpr int LDS_BYTES = 147456;
static_assert(att::NA_TAB + 2 * 512 * 4 <= LDS_BYTES, "LDS map");

__global__ void __launch_bounds__(512, 2) fwd_megakernel(Args a) {
    extern __shared__ __attribute__((aligned(16))) unsigned char lds_raw[];
    LAS unsigned char* lds = (LAS unsigned char*)lds_raw;
#define GSYNC() cg::this_grid().sync()
    unsigned char* const ws = a.ws;
    volatile LAS unsigned* xst = (volatile LAS unsigned*)(lds + LDS_BYTES - 16);
    if (threadIdx.x < 4) xst[threadIdx.x] = 0u;
    __syncthreads();
    XcdBarrier xb0 = xcd_barrier_post((unsigned*)(ws + WS_BAR), xst); (void)xb0;
    if ((const void*)a.c == (const void*)a.ws) GSYNC();
    prologue_phase(a, lds);
#define XSYNC() do { XcdBarrier xb_; xb_.bar = (unsigned*)(ws + WS_BAR); xb_.x = xb_xcc_id(); xb_.st = (volatile LAS unsigned*)(lds + LDS_BYTES - 16); xcd_barrier(xb_); } while (0)
    XSYNC();
    const Args* A = (const Args*)(ws + WS_ARGS);
#define WSP(T, off) ((T*)(ws + (off)))
#pragma unroll 1
    for (int l = 0; l < 2; ++l) {
        const int M = l == 0 ? MALL : MLAT;
#ifndef NORM_REP
#define NORM_REP 1
#endif
#pragma unroll 1
        for (int rep = 0; rep < NORM_REP; ++rep) {
        norm_phase(l == 0 ? (const void*)A->x : (const void*)WSP(bf16_t, WS_HB), l == 0, l == 0 ? A->ctx : WSP(float, WS_HC), MALL, A->g_mix + l * DM, WSP(float, WS_MODS) + l * 5 * 6144, 0, 1024, WSP(bf16_t, WS_U), WSP(const float, WS_PART), l == 0 ? 0 : 16, WSP(float, WS_HC));
        XSYNC();
        }
        {
            const int N = l == 0 ? 3072 : 1536;
            pg8::Gemm g{WSP(bf16_t, WS_U), WSP(const bf16_t, l == 0 ? WS_WQKV0 : WS_WQKV1), MALL, N, DM}; pg8::StaticOrder S; S.init(MALL, N, gridDim.x, blockIdx.x);
            EpiQKV E{WSP(bf16_t, WS_Q), (size_t)(WS_K - WS_Q) / 2, l == 0 ? DM : 256, l == 0 ? 4 : 1, WSP(float, WS_GAINS) + l * 128, l == 0 ? nullptr : WSP(const float, WS_ROPE)};
            pg8::gemm_phase<EpiQKV, pg8::StaticOrder, true, true>(lds, g, S, E);
        }
        XSYNC();
#ifndef ATT_REP
#define ATT_REP 1
#endif
#pragma unroll 1
        for (int rep = 0; rep < ATT_REP; ++rep) {
        if (l == 0) att::na_phase(lds, WSP(bf16_t, WS_Q), WSP(bf16_t, WS_K), WSP(bf16_t, WS_V), WSP(bf16_t, WS_O), A->na_rpb, -WSP(const float, WS_BND)[0]);
        else att::swa_phase(lds, WSP(bf16_t, WS_Q), WSP(bf16_t, WS_K), WSP(bf16_t, WS_V), WSP(bf16_t, WS_O), A->swa_sink, -WSP(const float, WS_BND)[1]);
        XSYNC();
        }
        {
            pg8::Gemm g{WSP(bf16_t, WS_O), WSP(const bf16_t, l == 0 ? WS_WO0 : WS_WO1), M, DM, DM}; SplitOrder S; S.init(DM, DM, l == 0 ? 4 : 0, gridDim.x, blockIdx.x);
            EpiRes E{l == 0 ? (const void*)A->x : (const void*)WSP(bf16_t, WS_HB), WSP(float, WS_HC), WSP(bf16_t, WS_HB), WSP(float, WS_HC), WSP(float, WS_MODS) + l * 5 * 6144 + 2048, WSP(float, WS_PART), l == 0, 0};
            pg8::gemm_phase<EpiRes, SplitOrder, true, true>(lds, g, S, E);
        }
        XSYNC();
#pragma unroll 1
        for (int rep = 0; rep < NORM_REP; ++rep) {
        norm_phase(WSP(bf16_t, WS_HB), 0, l == 0 ? A->ctx : WSP(float, WS_HC), M, A->g_mlp + l * DM, WSP(float, WS_MODS) + l * 5 * 6144, 3072, 4096, WSP(bf16_t, WS_U), WSP(const float, WS_PART), l == 0 ? 4 : 0, WSP(float, WS_HC));
        XSYNC();
        }
#ifndef UP_REP
#define UP_REP 1
#endif
#pragma unroll 1
        for (int rep = 0; rep < UP_REP; ++rep) {
        if (rep) XSYNC();
        {
            pg8::Gemm g{WSP(bf16_t, WS_U), WSP(const bf16_t, WS_W1) + (size_t)l * DM * DFF, M, DFF, DM}; pg8::StaticOrder S; S.init(M, DFF, gridDim.x, blockIdx.x);
            EpiRelu2 E{WSP(bf16_t, WS_HMID), DFF};
            pg8::gemm_phase<EpiRelu2, pg8::StaticOrder, true, true>(lds, g, S, E);
        }
        }
        XSYNC();
        {
            pg8::Gemm g{WSP(bf16_t, WS_HMID), WSP(const bf16_t, WS_W2) + (size_t)l * DM * DFF, M, DM, DFF}; SplitOrder S; S.init(DM, DFF, l == 0 ? 16 : 0, gridDim.x, blockIdx.x, true);
            EpiRes E{WSP(bf16_t, WS_HB), WSP(float, WS_HC), l == 0 ? (void*)WSP(bf16_t, WS_HB) : (void*)A->out, WSP(float, WS_HC), WSP(float, WS_MODS) + l * 5 * 6144 + 5120, WSP(float, WS_PART), 0, l == 1};
            pg8::gemm_phase<EpiRes, SplitOrder, true, true>(lds, g, S, E);
        }
        if (l == 0) XSYNC();
    }
#undef WSP
}

extern "C" void kernel_launch(void* const* d_in, const int* in_sizes, int n_in, void* d_out, int out_size, void* d_ws, size_t ws_size, hipStream_t stream) {
    static int grid_blocks = 0;
    if (grid_blocks == 0) {
        if (n_in != 20 || out_size != MLAT * DM || ws_size < WS_END) { fprintf(stderr, "kernel_launch: unexpected shapes (n_in %d out %d ws %zu)\n", n_in, out_size, ws_size); grid_blocks = -1; return; }
        int dev = 0, cus = 0, per_cu = 0;
        hipGetDevice(&dev);
        hipDeviceGetAttribute(&cus, hipDeviceAttributeMultiprocessorCount, dev);
        hipFuncSetAttribute((const void*)fwd_megakernel, hipFuncAttributeMaxDynamicSharedMemorySize, LDS_BYTES);
        hipOccupancyMaxActiveBlocksPerMultiprocessor(&per_cu, (const void*)fwd_megakernel, 512, LDS_BYTES);
        if (per_cu < 1) { fprintf(stderr, "kernel_launch: occupancy query says %d blocks per CU\n", per_cu); per_cu = 1; }
        grid_blocks = cus * per_cu;
    }
    if (grid_blocks < 0) return;
    if (hipMemsetAsync((unsigned char*)d_ws + WS_BAR, 0, XCD_BAR_WORDS * 4, stream) != hipSuccess) { fprintf(stderr, "kernel_launch: hipMemsetAsync of the barrier words failed\n"); return; }
    Args a{};
    const float** ap = (const float**)&a;
    for (int i = 0; i < 20; ++i) ap[i] = (const float*)d_in[i];
    a.out = (float*)d_out; a.ws = (unsigned char*)d_ws;
    void* args[] = {&a};
    hipError_t e = hipLaunchCooperativeKernel((const void*)fwd_megakernel, dim3(grid_blocks), dim3(512), args, LDS_BYTES, stream);
    if (e != hipSuccess) fprintf(stderr, "cooperative launch failed: %s (grid %d)\n", hipGetErrorString(e), grid_blocks);
}
```

```cpp
#include <hip/hip_runtime.h>
#include <hip/hip_cooperative_groups.h>
#include <cstdio>
#include <cstdint>
namespace cg = cooperative_groups;
namespace pg8 {
#define PG8_LAS __attribute__((address_space(3)))
typedef unsigned short bf16_t;
typedef short bf16x8 __attribute__((ext_vector_type(8)));
typedef float f32x4 __attribute__((ext_vector_type(4)));
typedef unsigned u32x4 __attribute__((ext_vector_type(4)));
constexpr int BM = 256, BK = 64, HALF = 128, HTB = HALF * BK * 2  , STAGE_BYTES = 8 * HTB, NXCD = 8, WGM = 8;

__host__ __device__ __forceinline__ int lds_byte(int r, int c) { const int st = (r >> 4) * 2 + (c >> 5), rr = r & 15, cc = c & 31, ob = rr * 64 + cc * 2; return st * 1024 + (ob ^ (((ob >> 9) & 1) << 5)); }
__host__ __device__ __forceinline__ void stage_rc(int b, int& R, int& C) { const int st = b / 1024, sb = b % 1024, swz = sb ^ (((sb >> 9) & 1) << 5); R = (st >> 1) * 16 + swz / 64; C = (st & 1) * 32 + (swz % 64) / 2; }
__host__ __device__ __forceinline__ int perm32(int rho) { const int n = rho >> 4, i = rho & 15; return 8 * (i >> 2) + 4 * n + (i & 3); }

struct Unit { int pm, pn, k0, nt; };
struct Gemm { const bf16_t* A; const bf16_t* Bt; int M, N, K; int krev; };

struct StaticOrder {
    int nM, nN, nwg, G, c;
    __host__ __device__ void init(int M, int N, int G_, int c_) { nM = M / BM; nN = N / BM; nwg = nM * nN; G = G_; c = c_; }
    __host__ __device__ bool next(int i, Unit& u) const {
        const long L = (long)i * G + c; if (L >= nwg) return false;
        int wgid = (int)L; { const int q = nwg / NXCD, r = nwg % NXCD, xcd = wgid % NXCD, off = wgid / NXCD; wgid = (xcd < r ? xcd * (q + 1) : r * (q + 1) + (xcd - r) * q) + off; }
        const int nig = WGM * nN, gid = wgid / nig, fm = gid * WGM, gsz = (nM - fm) < WGM ? (nM - fm) : WGM;
        u.pm = fm + ((wgid % nig) % gsz); u.pn = (wgid % nig) / gsz; u.k0 = 0; u.nt = 0; return true;
    }
    __device__ __forceinline__ void a_ready(const Unit&) const {}
    __device__ __forceinline__ void done(const Unit&) const {}
};

__device__ __forceinline__ unsigned cvt_pk_bf16(float lo, float hi) { unsigned r; asm volatile("v_cvt_pk_bf16_f32 %0, %1, %2" : "=v"(r) : "v"(lo), "v"(hi)); return r; }
template <class Epi, class Sched, bool ALIGN_EPI = false, bool SP2 = false>
__device__ __forceinline__ void gemm_phase(PG8_LAS unsigned char* lds, const Gemm g, const Sched& S, const Epi& E) {
    int tid_ = threadIdx.x; asm volatile("" : "+v"(tid_));
    const int tid = tid_, wid = __builtin_amdgcn_readfirstlane(tid >> 6), lane = tid & 63, wr = wid >> 2, wc = wid & 3, fr = lane & 15, fq = lane >> 4;
    const int K = g.K, ntf = K / BK;
    unsigned voffA[2], voffB[2];
#pragma unroll
    for (int i = 0; i < 2; ++i) { int R, C; stage_rc(tid * 16 + i * 8192, R, C); const int Rb = Epi::PERM ? ((R & ~31) + perm32(R & 31)) : R;
        voffA[i] = (unsigned)(R * K + C) * 2u; voffB[i] = (unsigned)(Rb * K + C) * 2u; }
    const size_t kstep = g.krev ? (size_t)0 - (size_t)(BK * 2) : (size_t)(BK * 2);
#define PG8_KOFF(U_) (g.krev ? (size_t)(((U_).nt ? (U_).nt : ntf) - 1) * (size_t)(BK * 2) : (size_t)0)
    const size_t hstep = (size_t)HALF * K * 2;
    const size_t tstep = 2 * hstep;
    const unsigned ldsw = (unsigned)wid * 1024u;
    const int aoff = lds_byte(wr * 64 + fr, fq * 8), boff = lds_byte(wc * 32 + fr, fq * 8);
#define PG8_SA(b, h) (((b) * 2 + (h)) * HTB)
#define PG8_SB(b, h) ((4 + (b) * 2 + (h)) * HTB)
#define PG8_STAGE(bufoff, gbase, voff) do { _Pragma("unroll") for (int _i = 0; _i < 2; ++_i) \
        __builtin_amdgcn_global_load_lds((const unsigned*)((const char*)(gbase) + (voff)[_i]), (PG8_LAS unsigned*)(lds + (bufoff) + ldsw + _i * 8192), 16, 0, 0); } while (0)
#define PG8_LDA(dst, b, h) do { _Pragma("unroll") for (int m = 0; m < 4; ++m) _Pragma("unroll") for (int k = 0; k < 2; ++k) dst[m][k] = *(const PG8_LAS bf16x8*)(lds + PG8_SA(b, h) + aoff + m * 2048 + k * 1024); } while (0)
#define PG8_LDB(dst, b, h) do { _Pragma("unroll") for (int n = 0; n < 2; ++n) _Pragma("unroll") for (int k = 0; k < 2; ++k) dst[n][k] = *(const PG8_LAS bf16x8*)(lds + PG8_SB(b, h) + boff + n * 2048 + k * 1024); } while (0)
#define PG8_MMA(ai, bj, At, Bt) do { __builtin_amdgcn_s_setprio(1); _Pragma("unroll") for (int m = 0; m < 4; ++m) _Pragma("unroll") for (int n = 0; n < 2; ++n) _Pragma("unroll") for (int k = 0; k < 2; ++k) \
        acc[ai][bj][m][n] = __builtin_amdgcn_mfma_f32_16x16x32_bf16(Bt[n][k], At[m][k], acc[ai][bj][m][n], 0, 0, 0); __builtin_amdgcn_s_setprio(0); } while (0)
#define PG8_WAIT_V(n) asm volatile("s_waitcnt vmcnt(" #n ")" ::: "memory")
#define PG8_WAIT_L(n) asm volatile("s_waitcnt lgkmcnt(" #n ")" ::: "memory")
#define PG8_BAR __builtin_amdgcn_s_barrier()
#define PG8_SCHED __builtin_amdgcn_sched_barrier(0)
    Unit cur, nxt; int ui = 0;
    if (!S.next(0, cur)) return;
    f32x4 acc[2][2][4][2];
#pragma unroll
    for (int a = 0; a < 2; ++a)
#pragma unroll
        for (int b = 0; b < 2; ++b)
#pragma unroll
            for (int m = 0; m < 4; ++m)
#pragma unroll
                for (int n = 0; n < 2; ++n) acc[a][b][m][n] = (f32x4){0.f, 0.f, 0.f, 0.f};
    bf16x8 At[4][2], B0[2][2], B1[2][2];
    const char* cA = (const char*)g.A + (size_t)cur.pm * tstep + (size_t)cur.k0 * 2 + PG8_KOFF(cur); const char* cB = (const char*)g.Bt + (size_t)cur.pn * tstep + (size_t)cur.k0 * 2 + PG8_KOFF(cur);
    S.a_ready(cur);
    if constexpr (SP2) {
        PG8_STAGE(PG8_SB(0, 0), cB, voffB); PG8_STAGE(PG8_SB(0, 1), cB + hstep, voffB); PG8_STAGE(PG8_SA(0, 0), cA, voffA); PG8_STAGE(PG8_SA(0, 1), cA + hstep, voffA);
        if (wr == 1) PG8_BAR;
        PG8_WAIT_V(2); PG8_BAR;
        PG8_STAGE(PG8_SB(1, 0), cB + kstep, voffB); PG8_STAGE(PG8_SA(1, 0), cA + kstep, voffA); PG8_STAGE(PG8_SB(1, 1), cB + hstep + kstep, voffB);
        PG8_WAIT_V(6); PG8_BAR;
    } else {
        PG8_STAGE(PG8_SB(0, 0), cB, voffB); PG8_STAGE(PG8_SA(0, 0), cA, voffA); PG8_STAGE(PG8_SB(0, 1), cB + hstep, voffB); PG8_STAGE(PG8_SA(0, 1), cA + hstep, voffA);
        if (wr == 1) PG8_BAR;
        PG8_WAIT_V(4); PG8_BAR;
        PG8_STAGE(PG8_SB(1, 0), cB + kstep, voffB); PG8_STAGE(PG8_SA(1, 0), cA + kstep, voffA); PG8_STAGE(PG8_SB(1, 1), cB + hstep + kstep, voffB);
        PG8_WAIT_V(6); PG8_BAR;
    }
    for (;;) {
        const bool has_next = S.next(ui + 1, nxt);
        const char* nA = has_next ? (const char*)g.A + (size_t)nxt.pm * tstep + (size_t)nxt.k0 * 2 + PG8_KOFF(nxt) : cA; const char* nB = has_next ? (const char*)g.Bt + (size_t)nxt.pn * tstep + (size_t)nxt.k0 * 2 + PG8_KOFF(nxt) : cB;
        const int nt = cur.nt ? cur.nt : ntf;
        for (int t = 0; t < nt; t += 2) {
            const bool last = (t == nt - 2);
            const char* a1 = cA + (size_t)(t + 1) * kstep;
            const char* a2 = last ? nA : cA + (size_t)(t + 2) * kstep; const char* b2 = last ? nB : cB + (size_t)(t + 2) * kstep;
            const char* a3 = a2 + kstep; const char* b3 = b2 + kstep;
            if (last && has_next) S.a_ready(nxt);
            if constexpr (SP2) {
            PG8_LDB(B0, 0, 0); PG8_LDB(B1, 0, 1); PG8_SCHED; PG8_LDA(At, 0, 0); PG8_STAGE(PG8_SA(1, 1), a1 + hstep, voffA);
            PG8_WAIT_V(8); PG8_WAIT_L(0); PG8_BAR; PG8_MMA(0, 0, At, B0); PG8_MMA(0, 1, At, B1); PG8_BAR; PG8_SCHED;
            PG8_LDA(At, 0, 1); PG8_STAGE(PG8_SB(0, 0), b2, voffB); PG8_STAGE(PG8_SB(0, 1), b2 + hstep, voffB); PG8_STAGE(PG8_SA(0, 0), a2, voffA);
            PG8_WAIT_V(8); PG8_WAIT_L(0); PG8_BAR; PG8_MMA(1, 0, At, B0); PG8_MMA(1, 1, At, B1); PG8_BAR; PG8_SCHED;
            PG8_LDB(B0, 1, 0); PG8_LDB(B1, 1, 1); PG8_SCHED; PG8_LDA(At, 1, 0); PG8_STAGE(PG8_SA(0, 1), a2 + hstep, voffA);
            PG8_WAIT_V(8); PG8_WAIT_L(0); PG8_BAR; PG8_MMA(0, 0, At, B0); PG8_MMA(0, 1, At, B1); PG8_BAR; PG8_SCHED;
            PG8_LDA(At, 1, 1); PG8_STAGE(PG8_SB(1, 0), b3, voffB); PG8_STAGE(PG8_SB(1, 1), b3 + hstep, voffB); PG8_STAGE(PG8_SA(1, 0), a3, voffA);
            PG8_WAIT_V(8); PG8_WAIT_L(0); PG8_BAR; PG8_MMA(1, 0, At, B0); PG8_MMA(1, 1, At, B1); PG8_BAR; PG8_SCHED;
            } else {
            PG8_LDB(B0, 0, 0); PG8_SCHED; PG8_LDA(At, 0, 0); PG8_STAGE(PG8_SA(1, 1), a1 + hstep, voffA);
            PG8_WAIT_L(8); PG8_BAR; PG8_WAIT_L(0); PG8_MMA(0, 0, At, B0); PG8_BAR; PG8_SCHED;
            PG8_LDB(B1, 0, 1); PG8_STAGE(PG8_SB(0, 0), b2, voffB);
            PG8_BAR; PG8_WAIT_L(0); PG8_MMA(0, 1, At, B1); PG8_BAR;
            PG8_LDA(At, 0, 1); PG8_STAGE(PG8_SA(0, 0), a2, voffA);
            PG8_BAR; PG8_WAIT_L(0); PG8_MMA(1, 0, At, B0); PG8_BAR; PG8_SCHED;
            PG8_STAGE(PG8_SB(0, 1), b2 + hstep, voffB);
            PG8_WAIT_V(6); PG8_BAR; PG8_MMA(1, 1, At, B1); PG8_BAR;
            PG8_LDB(B0, 1, 0); PG8_SCHED; PG8_LDA(At, 1, 0); PG8_STAGE(PG8_SA(0, 1), a2 + hstep, voffA);
            PG8_WAIT_L(8); PG8_BAR; PG8_WAIT_L(0); PG8_MMA(0, 0, At, B0); PG8_BAR; PG8_SCHED;
            PG8_LDB(B1, 1, 1); PG8_STAGE(PG8_SB(1, 0), b3, voffB);
            PG8_BAR; PG8_WAIT_L(0); PG8_MMA(0, 1, At, B1); PG8_BAR;
            PG8_LDA(At, 1, 1); PG8_STAGE(PG8_SA(1, 0), a3, voffA);
            PG8_BAR; PG8_WAIT_L(0); PG8_MMA(1, 0, At, B0); PG8_BAR; PG8_SCHED;
            PG8_STAGE(PG8_SB(1, 1), b3 + hstep, voffB);
            PG8_WAIT_V(6); PG8_BAR; PG8_MMA(1, 1, At, B1); PG8_BAR;
            }
        }
        if constexpr (ALIGN_EPI) { if (wr == 0) PG8_BAR; }
        if constexpr (!Epi::AFTER_DRAIN) { E(acc, cur, wr, wc, fr, fq); S.done(cur); }
        if (!has_next) break;
#pragma unroll
        for (int a = 0; a < 2; ++a)
#pragma unroll
            for (int b = 0; b < 2; ++b)
#pragma unroll
                for (int m = 0; m < 4; ++m)
#pragma unroll
                    for (int n = 0; n < 2; ++n) acc[a][b][m][n] = (f32x4){0.f, 0.f, 0.f, 0.f};
        cur = nxt; cA = nA; cB = nB; ++ui;
        if constexpr (ALIGN_EPI) { if (wr == 1) PG8_BAR; }
    }
    PG8_WAIT_V(0);
    if constexpr (!ALIGN_EPI) { if (wr == 0) PG8_BAR; }
    PG8_BAR;
    if constexpr (Epi::AFTER_DRAIN) { E.fused(acc, cur, wr, wc, fr, fq, lds, wid, lane); S.done(cur); }
#undef PG8_SA
#undef PG8_SB
#undef PG8_STAGE
#undef PG8_LDA
#undef PG8_LDB
#undef PG8_MMA
#undef PG8_WAIT_V
#undef PG8_WAIT_L
#undef PG8_BAR
#undef PG8_SCHED
}
}

#define LAS __attribute__((address_space(3)))
constexpr int NB = 4, SEQ = 8192, DM = 1024, NCTX = 256, NHEAD = 16, DFF = 4096;
constexpr int MLAT = NB * SEQ;
constexpr int MCTX = NB * NCTX;
constexpr int MALL = MLAT + MCTX;
constexpr float EPS = 1e-6f;
constexpr float LOG2E = 1.4426950408889634f;
constexpr float QSCALE = 0.125f * LOG2E;
constexpr float NEGBIG = -1e30f;

constexpr size_t MiB = 1u << 20;
constexpr size_t WS_MODS = 1 * MiB;
constexpr size_t WS_ROPE = 1 * MiB + 512 * 1024;
constexpr size_t WS_GAINS = 1 * MiB + 768 * 1024;
constexpr size_t WS_BND = 1 * MiB + 896 * 1024;
constexpr size_t WS_BAR = 64 * 1024;
constexpr size_t WS_ARGS = 0;
constexpr size_t WS_WQKV0 = 2 * MiB, WS_WO0 = 8 * MiB, WS_WQKV1 = 10 * MiB, WS_WO1 = 13 * MiB, WS_W1 = 16 * MiB, WS_W2 = 32 * MiB;
constexpr size_t WS_HC = 48 * MiB;
constexpr size_t WS_U = 52 * MiB;
constexpr size_t WS_Q = 118 * MiB, WS_K = 184 * MiB, WS_V = 250 * MiB, WS_O = 316 * MiB;
constexpr size_t WS_HMID = 118 * MiB;
constexpr size_t WS_PART = 382 * MiB;
constexpr size_t WS_HB = 446 * MiB;
constexpr size_t WS_END = 510 * MiB;

typedef pg8::f32x4 f32x4;
typedef pg8::bf16x8 bf16x8;
typedef unsigned short bf16_t;
typedef unsigned u32x4 __attribute__((ext_vector_type(4)));
typedef unsigned u32x2 __attribute__((ext_vector_type(2)));
typedef float f32x2_t __attribute__((ext_vector_type(2)));
typedef __bf16 bf16x2_t __attribute__((ext_vector_type(2)));
typedef short s16x4 __attribute__((ext_vector_type(4)));
__device__ __forceinline__ unsigned pkbf(float lo, float hi) { f32x2_t v = {lo, hi}; bf16x2_t b = __builtin_convertvector(v, bf16x2_t); return __builtin_bit_cast(unsigned, b); }

template <int CTRL> __device__ __forceinline__ float dppf(float v) { return __uint_as_float((unsigned)__builtin_amdgcn_update_dpp(0, (int)__float_as_uint(v), CTRL, 0xF, 0xF, true)); }
__device__ __forceinline__ float xsum4(float v) {
    auto a = __builtin_amdgcn_permlane16_swap(__float_as_uint(v), __float_as_uint(v), false, false);
    v = __uint_as_float(a[0]) + __uint_as_float(a[1]);
    auto b = __builtin_amdgcn_permlane32_swap(__float_as_uint(v), __float_as_uint(v), false, false);
    return __uint_as_float(b[0]) + __uint_as_float(b[1]);
}
__device__ __forceinline__ float wave_sum64(float v) {
    v += dppf<0xB1>(v); v += dppf<0x4E>(v); v += dppf<0x141>(v); v += dppf<0x140>(v);
    return xsum4(v);
}

struct EpiRelu2 {
    static constexpr bool PERM = true, AFTER_DRAIN = false;
    bf16_t* O; int ldc;
    __device__ __forceinline__ void operator()(const f32x4 (&acc)[2][2][4][2], const pg8::Unit& u, int wr, int wc, int fr, int fq) const {
        const int row0 = u.pm * 256 + wr * 64 + fr, col0 = u.pn * 256 + wc * 32 + 8 * fq;
#pragma unroll
        for (int ai = 0; ai < 2; ++ai)
#pragma unroll
            for (int m = 0; m < 4; ++m) { bf16_t* rowp = O + (size_t)(row0 + ai * 128 + m * 16) * ldc + col0;
#pragma unroll
                for (int bj = 0; bj < 2; ++bj) { f32x4 v0 = acc[ai][bj][m][0], v1 = acc[ai][bj][m][1];
#pragma unroll
                    for (int i = 0; i < 4; ++i) { float a = fmaxf(v0[i], 0.f), b = fmaxf(v1[i], 0.f); v0[i] = a * a; v1[i] = b * b; }
                    u32x4 w; w.x = pkbf(v0[0], v0[1]); w.y = pkbf(v0[2], v0[3]); w.z = pkbf(v1[0], v1[1]); w.w = pkbf(v1[2], v1[3]);
                    *(u32x4*)(rowp + bj * 128) = w; } }
    }
};
struct SplitOrder {
    pg8::StaticOrder lat; int S, ntc, nr;
    __device__ void init(int N, int K, int S_, int G_, int c_, bool rev = false) { lat.init(MLAT, N, G_, c_); S = S_; ntc = S_ ? K / 64 / S_ : 0; nr = (rev && lat.nwg % G_ == 0) ? lat.nwg / G_ : 0; }
    __device__ bool next(int i, pg8::Unit& u) const {
        if (nr > 0 && i < nr) return lat.next(nr - 1 - i, u);
        if (lat.next(i, u)) return true;
        const int j = i * lat.G + lat.c - lat.nwg; if (j >= 16 * S) return false;
        const int tile = j / S, ch = j - tile * S; u.pm = 128 + (tile >> 2); u.pn = tile & 3; u.k0 = ch * ntc * 64; u.nt = ntc; return true;
    }
    __device__ __forceinline__ void a_ready(const pg8::Unit&) const {}
    __device__ __forceinline__ void done(const pg8::Unit&) const {}
};
struct EpiRes {
    static constexpr bool PERM = true, AFTER_DRAIN = false;
    const void* base_lat; const float* base_ctx; void* out_lat; float* out_ctx; const float* gate; float* part; int base_f32, out_f32;
    __device__ __forceinline__ void operator()(const f32x4 (&acc)[2][2][4][2], const pg8::Unit& u, int wr, int wc, int fr, int fq) const {
        const bool isctx = u.pm >= 128; const int s = isctx ? 4 : (u.pm >> 5);
        const int col0 = u.pn * 256 + wc * 32 + 8 * fq;
        const float* gp = gate + s * 6144 + col0;
        int row0 = (isctx ? u.pm - 128 : u.pm) * 256 + wr * 64 + fr; asm volatile("" : "+v"(row0));
        f32x4 g[2][2];
#pragma unroll
        for (int bj = 0; bj < 2; ++bj) { g[bj][0] = *(const f32x4*)(gp + bj * 128); g[bj][1] = *(const f32x4*)(gp + bj * 128 + 4); }
        if (u.nt != 0) {
            float* pp = part + (size_t)(u.k0 / (u.nt * 64)) * MCTX * DM;
#pragma unroll
            for (int ai = 0; ai < 2; ++ai)
#pragma unroll
                for (int m = 0; m < 4; ++m) { float* o = pp + (size_t)(row0 + ai * 128 + m * 16) * DM + col0;
#pragma unroll
                    for (int bj = 0; bj < 2; ++bj)
#pragma unroll
                        for (int n = 0; n < 2; ++n) *(f32x4*)(o + bj * 128 + 4 * n) = g[bj][n] * acc[ai][bj][m][n]; }
            return;
        }
        const bool bf = isctx || base_f32, of = isctx || out_f32;
        const float* bpf = isctx ? base_ctx : (const float*)base_lat; float* opf = isctx ? out_ctx : (float*)out_lat;
        const bf16_t* bph = (const bf16_t*)base_lat; bf16_t* oph = (bf16_t*)out_lat;
#pragma unroll
        for (int ai = 0; ai < 2; ++ai)
#pragma unroll
            for (int m = 0; m < 4; ++m) { const size_t off = (size_t)(row0 + ai * 128 + m * 16) * DM + col0;
#pragma unroll
                for (int bj = 0; bj < 2; ++bj) {
                    f32x4 b0, b1;
                    if (bf) { b0 = *(const f32x4*)(bpf + off + bj * 128); b1 = *(const f32x4*)(bpf + off + bj * 128 + 4); }
                    else { const u32x4 w = *(const u32x4*)(bph + off + bj * 128);
                        b0 = (f32x4){__uint_as_float(w.x << 16), __uint_as_float(w.x & 0xffff0000u), __uint_as_float(w.y << 16), __uint_as_float(w.y & 0xffff0000u)};
                        b1 = (f32x4){__uint_as_float(w.z << 16), __uint_as_float(w.z & 0xffff0000u), __uint_as_float(w.w << 16), __uint_as_float(w.w & 0xffff0000u)}; }
                    const f32x4 o0 = b0 + g[bj][0] * acc[ai][bj][m][0], o1 = b1 + g[bj][1] * acc[ai][bj][m][1];
                    if (of) { *(f32x4*)(opf + off + bj * 128) = o0; *(f32x4*)(opf + off + bj * 128 + 4) = o1; }
                    else { u32x4 w; w.x = pkbf(o0[0], o0[1]); w.y = pkbf(o0[2], o0[3]); w.z = pkbf(o1[0], o1[1]); w.w = pkbf(o1[2], o1[3]); *(u32x4*)(oph + off + bj * 128) = w; } } }
    }
};
struct EpiQKV {
    static constexpr bool PERM = true, AFTER_DRAIN = false;
    bf16_t* Q; size_t kstride; int kvpitch; int nk_tiles;
    const float* gains; const float* rope;
    __device__ __forceinline__ void operator()(const f32x4 (&acc)[2][2][4][2], const pg8::Unit& u, int wr, int wc, int fr, int fq) const {
        const int pn = u.pn; const int kind = pn < 4 ? 0 : (pn < 4 + nk_tiles ? 1 : 2);
        const int hd = (kind == 0 ? pn : (kind == 1 ? pn - 4 : pn - 4 - nk_tiles)) * 4 + wc;
        bf16_t* dst = Q + (size_t)kind * kstride + hd * 64 + 8 * fq; const int pitch = kind == 0 ? DM : kvpitch;
        const float* gp = gains + (kind & 1) * 64 + 8 * fq;
        const bool dorope = (rope != nullptr) && kind < 2 && u.pm < 128;
        const float* rp = rope + 8 * (fq & 1);
        int rbase = u.pm * 256 + wr * 64 + fr; asm volatile("" : "+v"(rbase));
        const int paddr = ((fr + 16 * fq) ^ 32) << 2;
#pragma unroll
        for (int ai = 0; ai < 2; ++ai)
#pragma unroll
            for (int m = 0; m < 4; ++m) {
                const int row = rbase + ai * 128 + m * 16;
                float rs = 1.0f;
                if (kind < 2) {
                    float ss = 0.f;
#pragma unroll
                    for (int bj = 0; bj < 2; ++bj)
#pragma unroll
                        for (int n = 0; n < 2; ++n) { const f32x4 x = acc[ai][bj][m][n]; ss += (x[0] * x[0] + x[1] * x[1]) + (x[2] * x[2] + x[3] * x[3]); }
                    ss = xsum4(ss);
                    rs = rsqrtf(ss * (1.0f / 64.0f) + EPS);
                }
                const int t = row & (SEQ - 1);
#pragma unroll
                for (int bj = 0; bj < 2; ++bj) {
                    f32x4 v0 = acc[ai][bj][m][0], v1 = acc[ai][bj][m][1];
                    if (kind < 2) {
                        v0 = v0 * rs * *(const f32x4*)(gp + 32 * bj); v1 = v1 * rs * *(const f32x4*)(gp + 32 * bj + 4);
                        if (dorope) {
                            const int pos = bj ? (t & 63) : (t >> 6);
                            const f32x4 c0 = *(const f32x4*)(rp + pos * 16), c1 = *(const f32x4*)(rp + pos * 16 + 4);
                            const f32x4 s0 = *(const f32x4*)(rp + 2048 + pos * 16), s1 = *(const f32x4*)(rp + 2048 + pos * 16 + 4);
                            f32x4 o0, o1;
#pragma unroll
                            for (int i = 0; i < 4; ++i) { const float p0 = __uint_as_float((unsigned)__builtin_amdgcn_ds_bpermute(paddr, (int)__float_as_uint(v0[i]))) * s0[i], p1 = __uint_as_float((unsigned)__builtin_amdgcn_ds_bpermute(paddr, (int)__float_as_uint(v1[i]))) * s1[i];
                                o0[i] = v0[i] * c0[i] + (fq >= 2 ? p0 : -p0); o1[i] = v1[i] * c1[i] + (fq >= 2 ? p1 : -p1); }
                            v0 = o0; v1 = o1;
                        }
                    }
                    u32x4 w; w.x = pkbf(v0[0], v0[1]); w.y = pkbf(v0[2], v0[3]); w.z = pkbf(v1[0], v1[1]); w.w = pkbf(v1[2], v1[3]);
                    *(u32x4*)(dst + (size_t)row * pitch + 32 * bj) = w;
                }
                asm volatile("" ::: "memory");
            }
    }
};

namespace att {
#define DMA_SYNC() do { asm volatile("s_waitcnt vmcnt(0)" ::: "memory"); __syncthreads(); } while (0)
__device__ __forceinline__ float red_max4(float v) {
    auto a = __builtin_amdgcn_permlane16_swap(__float_as_uint(v), __float_as_uint(v), false, false);
    v = fmaxf(__uint_as_float(a[0]), __uint_as_float(a[1]));
    auto b = __builtin_amdgcn_permlane32_swap(__float_as_uint(v), __float_as_uint(v), false, false);
    return fmaxf(__uint_as_float(b[0]), __uint_as_float(b[1]));
}
__device__ __forceinline__ float red_sum4(float v) {
    auto a = __builtin_amdgcn_permlane16_swap(__float_as_uint(v), __float_as_uint(v), false, false);
    v = __uint_as_float(a[0]) + __uint_as_float(a[1]);
    auto b = __builtin_amdgcn_permlane32_swap(__float_as_uint(v), __float_as_uint(v), false, false);
    return __uint_as_float(b[0]) + __uint_as_float(b[1]);
}
typedef short v4i16_t __attribute__((ext_vector_type(4)));
__device__ __forceinline__ s16x4 vtr(const LAS unsigned char* p) { return __builtin_bit_cast(s16x4, __builtin_amdgcn_ds_read_tr16_b64_v4i16((LAS v4i16_t*)p)); }
__device__ __forceinline__ bf16x8 cat8(s16x4 a, s16x4 b) { return (bf16x8){a[0], a[1], a[2], a[3], b[0], b[1], b[2], b[3]}; }
__device__ __forceinline__ bf16x8 pack8(const f32x4& a, const f32x4& b) { u32x4 w; w.x = pkbf(a[0], a[1]); w.y = pkbf(a[2], a[3]); w.z = pkbf(b[0], b[1]); w.w = pkbf(b[2], b[3]); return __builtin_bit_cast(bf16x8, w); }

struct DmaLane { unsigned koff, voff; };
__device__ __forceinline__ DmaLane dma_lane(int pitch, int col0, int w, int lane) {
    const int key = 8 * w + (lane >> 3), slot = lane & 7;
    const int c8k = slot ^ (key & 7), c8v = (((slot >> 1) ^ ((key >> 1) & 3)) << 1) | (slot & 1);
    DmaLane d; d.koff = (unsigned)((key * pitch + col0 + c8k * 8) * 2); d.voff = (unsigned)((key * pitch + col0 + c8v * 8) * 2); return d;
}
__device__ __forceinline__ void glds16(const unsigned char* sbase, unsigned voff, unsigned lds_dst) { unsigned keep;
    asm volatile("s_mov_b32 %0, m0\n\ts_mov_b32 m0, %3\n\ts_nop 0\n\tglobal_load_lds_dwordx4 %1, %2\n\ts_mov_b32 m0, %0" : "=&s"(keep) : "v"(voff), "s"(sbase), "s"(lds_dst) : "memory"); }
template <int NHT> __device__ __forceinline__ void dma_tile(LAS unsigned char* buf, const bf16_t* Kg, const bf16_t* Vg, size_t row0, int pitch, const DmaLane& d, int w) {
    const unsigned char* kb = (const unsigned char*)Kg + row0 * (size_t)pitch * 2; const unsigned char* vb = (const unsigned char*)Vg + row0 * (size_t)pitch * 2;
    const unsigned l0 = (unsigned)__builtin_amdgcn_readfirstlane((int)(unsigned)(uintptr_t)buf + w * 1024);
#pragma unroll
    for (int hh = 0; hh < NHT; ++hh) {
        glds16(kb, d.koff + hh * 128, l0 + hh * 8192);
        glds16(vb, d.voff + hh * 128, l0 + NHT * 8192 + hh * 8192); }
}

template <int NB16> __device__ __forceinline__ float exp_step(f32x4 (&S)[NB16]) {
    float sum = 0.f;
#pragma unroll
    for (int k = 0; k < NB16; ++k)
#pragma unroll
        for (int i = 0; i < 4; ++i) { S[k][i] = __builtin_amdgcn_exp2f(S[k][i]); sum += S[k][i]; }
    return sum;
}

template <int MASK, int GPB, int SB = 1> __device__ __forceinline__ void full_tile(f32x4 (&O)[4][4], float (&ls)[4], const bf16x8 (&qf)[4][2], float negb,
                                                            const LAS unsigned char* Kt, const LAS unsigned char* Vt, int lane, int rel0) {
    const int l15 = lane & 15, g = lane >> 4, q4 = l15 >> 2;
    const LAS unsigned char* kb0 = Kt + l15 * 128;
    const int kx0 = ((g) ^ (l15 & 7)) << 4, kx1 = ((4 + g) ^ (l15 & 7)) << 4;
    const LAS unsigned char* vrow = Vt + (4 * g + q4) * 128 + (lane & 3) * 8;
    const int swz = (2 * (g & 1) + (q4 >> 1)) & 3;
    const f32x4 cinit = (f32x4){negb, negb, negb, negb};
#pragma unroll
    for (int gh = 0; gh < 4 / GPB; ++gh) {
        f32x4 S[GPB][4];
#pragma unroll
        for (int kb = 0; kb < 4; ++kb) {
            const bf16x8 kf0 = *(const LAS bf16x8*)(kb0 + (16 * kb) * 128 + kx0), kf1 = *(const LAS bf16x8*)(kb0 + (16 * kb) * 128 + kx1);
#pragma unroll
            for (int gi = 0; gi < GPB; ++gi) { S[gi][kb] = __builtin_amdgcn_mfma_f32_16x16x32_bf16(kf0, qf[GPB * gh + gi][0], cinit, 0, 0, 0);
                S[gi][kb] = __builtin_amdgcn_mfma_f32_16x16x32_bf16(kf1, qf[GPB * gh + gi][1], S[gi][kb], 0, 0, 0); } }
        bf16x8 pf[GPB][2];
#pragma unroll
        for (int gi = 0; gi < GPB; ++gi) {
            if (MASK) {
#pragma unroll
                for (int kb = 0; kb < 4; ++kb)
#pragma unroll
                    for (int i = 0; i < 4; ++i) { const int rel = rel0 + 16 * kb + 4 * g + i; S[gi][kb][i] = ((unsigned)(rel + 128) > 256u) ? NEGBIG : S[gi][kb][i]; }
            }
            ls[GPB * gh + gi] += exp_step<4>(S[gi]);
            pf[gi][0] = pack8(S[gi][0], S[gi][1]); pf[gi][1] = pack8(S[gi][2], S[gi][3]);
        }
#pragma unroll
        for (int kc = 0; kc < 2; ++kc)
#pragma unroll
            for (int db = 0; db < 4; ++db) {
                const LAS unsigned char* va = vrow + ((db ^ swz) << 5) + (32 * kc) * 128;
                const bf16x8 vf = cat8(vtr(va), vtr(va + 16 * 128));
#pragma unroll
                for (int gi = 0; gi < GPB; ++gi) O[GPB * gh + gi][db] = __builtin_amdgcn_mfma_f32_16x16x32_bf16(vf, pf[gi][kc], O[GPB * gh + gi][db], 0, 0, 0);
            }
        if (SB == 1) __builtin_amdgcn_sched_barrier(0); else if (SB == 2) __builtin_amdgcn_sched_barrier(0x108);
    }
}

__device__ __forceinline__ void na_local_tile(f32x4 (&O)[4][4], float (&ls)[4], const bf16x8 (&qf)[4][2], float negb,
                                              const LAS unsigned char* Kt, const LAS unsigned char* Vt, int lane, const LAS float* bias_row, bool rowvalid) {
    const int l15 = lane & 15, g = lane >> 4, q4 = l15 >> 2;
    const LAS unsigned char* kb0 = Kt + l15 * 128;
    const int kx0 = ((g) ^ (l15 & 7)) << 4, kx1 = ((4 + g) ^ (l15 & 7)) << 4;
    const LAS unsigned char* vrow = Vt + (4 * g + q4) * 128 + (lane & 3) * 8;
    const int swz = (2 * (g & 1) + (q4 >> 1)) & 3;
#pragma unroll
    for (int grp = 0; grp < 4; ++grp) {
        const int kwin = grp == 0 ? 0 : (grp == 1 ? 8 : (grp == 2 ? 24 : 32));
        f32x4 S[2];
#pragma unroll
        for (int k2 = 0; k2 < 2; ++k2) {
            const bf16x8 kf0 = *(const LAS bf16x8*)(kb0 + (kwin + 16 * k2) * 128 + kx0), kf1 = *(const LAS bf16x8*)(kb0 + (kwin + 16 * k2) * 128 + kx1);
            S[k2] = __builtin_amdgcn_mfma_f32_16x16x32_bf16(kf0, qf[grp][0], (f32x4){negb, negb, negb, negb}, 0, 0, 0);
            S[k2] = __builtin_amdgcn_mfma_f32_16x16x32_bf16(kf1, qf[grp][1], S[k2], 0, 0, 0); }
        const int c = 16 * grp + l15; const int c0 = rowvalid ? min(max(c - 8, 0), 48) : 4096;
        const LAS float* bl = bias_row + (15 - c + 4 * g);
#pragma unroll
        for (int k2 = 0; k2 < 2; ++k2)
#pragma unroll
            for (int i = 0; i < 4; ++i) { const int kc = kwin + 16 * k2 + 4 * g + i; const float bias = bl[kwin + 16 * k2 + i];
                S[k2][i] = ((unsigned)(kc - c0) < 16u) ? S[k2][i] + bias : NEGBIG; }
        ls[grp] += exp_step<2>(S);
        const bf16x8 pf = pack8(S[0], S[1]);
#pragma unroll
        for (int db = 0; db < 4; ++db) {
            const LAS unsigned char* va = vrow + ((db ^ swz) << 5) + kwin * 128;
            const bf16x8 vf = cat8(vtr(va), vtr(va + 16 * 128));
            O[grp][db] = __builtin_amdgcn_mfma_f32_16x16x32_bf16(vf, pf, O[grp][db], 0, 0, 0);
        }
        __builtin_amdgcn_sched_barrier(0x108);
    }
}

__device__ __forceinline__ void store_group(const f32x4 (&Og)[4], float inv, bf16_t* orow, int g) {
#pragma unroll
    for (int db = 0; db < 4; ++db) { u32x2 w; w.x = pkbf(Og[db][0] * inv, Og[db][1] * inv); w.y = pkbf(Og[db][2] * inv, Og[db][3] * inv);
        *(u32x2*)(orow + 16 * db + 4 * g) = w; }
}

template <int NI> __device__ __forceinline__ void ring_wait() { asm volatile("s_waitcnt vmcnt(%0)" :: "n"(2 * NI) : "memory"); __syncthreads(); }
__device__ __forceinline__ void drain_wait() { asm volatile("s_waitcnt vmcnt(0)" ::: "memory"); __syncthreads(); }
__device__ __forceinline__ int item_of(int it, int nmain, int ntotal) {
    const int bid = blockIdx.x, G = gridDim.x;
    if (G == 256 && nmain == 1024) { if (it < 4) return 128 * (bid & 7) + 32 * it + (bid >> 3); const int e = nmain + (it - 4) * 256 + bid; return e < ntotal ? e : -1; }
    const int e = bid + it * G; return e < ntotal ? e : -1;
}

constexpr int NA_BUF = 32768;
constexpr int NA_TAB = 4 * NA_BUF;
constexpr int NA_ITEMS_LAT = NB * 8 * 32, NA_ITEMS = NA_ITEMS_LAT + NB * 8;
__device__ __forceinline__ void na_phase(LAS unsigned char* lds, const bf16_t* Q, const bf16_t* K, const bf16_t* V, bf16_t* Ob, const float* rpb, float negb) {
    int tid_ = threadIdx.x; asm volatile("" : "+v"(tid_));
    const int tid = tid_, lane = tid & 63, w = __builtin_amdgcn_readfirstlane(tid >> 6), l15 = lane & 15, g = lane >> 4;
    LAS float* tab = (LAS float*)(lds + NA_TAB);
    for (int it = 0;; ++it) {
        const int item = item_of(it, NA_ITEMS_LAT, NA_ITEMS); if (item < 0) break;
        const bool isctx = item >= NA_ITEMS_LAT;
        int b, hp, rq;
        if (!isctx) { b = item >> 8; hp = (item >> 5) & 7; rq = item & 31; } else { const int j = item - NA_ITEMS_LAT; b = j >> 3; hp = j & 7; rq = 0; }
        const int hh = w >> 2, head = 2 * hp + hh;
        const size_t ctx0 = (size_t)(MLAT + b * NCTX), lat0 = (size_t)(b * SEQ);
        const int kr_lo = min(max(4 * rq - 4, 0), 120), kr_hi = min(max(4 * rq - 1, 0), 120) + 8;
        const int NT = 4 + (isctx ? 0 : kr_hi - kr_lo);
        const DmaLane dl = dma_lane(DM, hp * 128, w, lane);
#define NA_ROW0(t) ((t) < 4 ? ctx0 + 64 * (t) : ((t) < NT ? lat0 + (size_t)(kr_lo + (t) - 4) * 64 : ctx0))
        dma_tile<2>(lds, K, V, NA_ROW0(0), DM, dl, w);
        dma_tile<2>(lds + NA_BUF, K, V, NA_ROW0(1), DM, dl, w);
        dma_tile<2>(lds + 2 * NA_BUF, K, V, NA_ROW0(2), DM, dl, w);
        for (int i = tid; i < 2 * 465; i += 512) { const int h2 = i / 465, e = i - h2 * 465; tab[h2 * 512 + e] = rpb[(2 * hp + h2) * 465 + e] * LOG2E; }
        const int r = 4 * rq + (w & 3);
        const size_t qrow0 = isctx ? (size_t)(MLAT + b * NCTX + (w & 3) * 64) : (size_t)(b * SEQ + r * 64);
        bf16x8 qf[4][2];
#pragma unroll
        for (int grp = 0; grp < 4; ++grp)
#pragma unroll
            for (int ds = 0; ds < 2; ++ds) qf[grp][ds] = *(const bf16x8*)(Q + (qrow0 + 16 * grp + l15) * DM + head * 64 + 32 * ds + 8 * g);
        f32x4 O[4][4]; float ls[4];
#pragma unroll
        for (int grp = 0; grp < 4; ++grp) { ls[grp] = 0.f;
#pragma unroll
            for (int db = 0; db < 4; ++db) O[grp][db] = (f32x4){0.f, 0.f, 0.f, 0.f}; }
        const int r0w = min(max(r - 4, 0), 120);
        drain_wait();
        for (int t = 0; t < 4; ++t) {
            dma_tile<2>(lds + ((t + 3) & 3) * NA_BUF, K, V, NA_ROW0(t + 3), DM, dl, w);
            const LAS unsigned char* buf = lds + (t & 3) * NA_BUF;
            full_tile<0, 1, 2>(O, ls, qf, negb, buf + hh * 8192, buf + 2 * 8192 + hh * 8192, lane, 0);
            ring_wait<4>();
        }
        for (int t = 4; t < NT; ++t) {
            dma_tile<2>(lds + ((t + 3) & 3) * NA_BUF, K, V, NA_ROW0(t + 3), DM, dl, w);
            const LAS unsigned char* buf = lds + (t & 3) * NA_BUF;
            const int kr = kr_lo + t - 4; const bool rv = kr >= r0w && kr < r0w + 8;
            if (rv) na_local_tile(O, ls, qf, negb, buf + hh * 8192, buf + 2 * 8192 + hh * 8192, lane, tab + hh * 512 + (kr - r + 7) * 31, true);
            ring_wait<4>();
        }
#undef NA_ROW0
#pragma unroll
        for (int grp = 0; grp < 4; ++grp) { const float lt = red_sum4(ls[grp]); store_group(O[grp], __builtin_amdgcn_rcpf(lt), Ob + (qrow0 + 16 * grp + l15) * DM + head * 64, g); }
    }
}

constexpr int SW_BUF = 16384;
constexpr int SW_ITEMS = NB * 4 * 64;
__device__ __forceinline__ void swa_phase(LAS unsigned char* lds, const bf16_t* Q, const bf16_t* K, const bf16_t* V, bf16_t* Ob, const float* sink, float negb) {
    int tid_ = threadIdx.x; asm volatile("" : "+v"(tid_));
    const int tid = tid_, lane = tid & 63, w = __builtin_amdgcn_readfirstlane(tid >> 6), l15 = lane & 15, g = lane >> 4;
    for (int it = 0;; ++it) {
        const int item = item_of(it, SW_ITEMS, SW_ITEMS); if (item < 0) break;
        const int b = item >> 8, kvh = (item >> 6) & 3, tb = item & 63;
        const size_t ctx0 = (size_t)(MLAT + b * NCTX), lat0 = (size_t)(b * SEQ);
        const int i_lo = tb == 0 ? 2 : 0, i_hi = tb == 63 ? 4 : 6;
        const int NT = 4 + (i_hi - i_lo);
        const DmaLane dl = dma_lane(256, kvh * 64, w, lane);
#define SW_ROW0(t) ((t) < 4 ? ctx0 + 64 * (t) : ((t) < NT ? lat0 + (size_t)(128 * tb - 128 + 64 * (i_lo + (t) - 4)) : ctx0))
        dma_tile<1>(lds, K, V, SW_ROW0(0), 256, dl, w);
        dma_tile<1>(lds + SW_BUF, K, V, SW_ROW0(1), 256, dl, w);
        dma_tile<1>(lds + 2 * SW_BUF, K, V, SW_ROW0(2), 256, dl, w);
        const int tq = 128 * tb + 16 * w;
        const size_t qrow = (size_t)(b * SEQ + tq + l15);
        bf16x8 qf[4][2];
#pragma unroll
        for (int grp = 0; grp < 4; ++grp)
#pragma unroll
            for (int ds = 0; ds < 2; ++ds) qf[grp][ds] = *(const bf16x8*)(Q + qrow * DM + (4 * kvh + grp) * 64 + 32 * ds + 8 * g);
        f32x4 O[4][4]; float ls[4];
#pragma unroll
        for (int grp = 0; grp < 4; ++grp) { ls[grp] = 0.f;
#pragma unroll
            for (int db = 0; db < 4; ++db) O[grp][db] = (f32x4){0.f, 0.f, 0.f, 0.f}; }
        drain_wait();
        for (int t = 0; t < 4; ++t) {
            dma_tile<1>(lds + ((t + 3) & 3) * SW_BUF, K, V, SW_ROW0(t + 3), 256, dl, w);
            const LAS unsigned char* buf = lds + (t & 3) * SW_BUF;
            full_tile<0, 2, 2>(O, ls, qf, negb, buf, buf + 8192, lane, 0);
            ring_wait<2>();
        }
        for (int t = 4; t < NT; ++t) {
            dma_tile<1>(lds + ((t + 3) & 3) * SW_BUF, K, V, SW_ROW0(t + 3), 256, dl, w);
            const LAS unsigned char* buf = lds + (t & 3) * SW_BUF;
            const int start = 128 * tb - 128 + 64 * (i_lo + t - 4);
            if (start + 63 >= tq - 128 && start <= tq + 15 + 128)
                full_tile<1, 2, 2>(O, ls, qf, negb, buf, buf + 8192, lane, start - (tq + l15));
            ring_wait<2>();
        }
#undef SW_ROW0
#pragma unroll
        for (int grp = 0; grp < 4; ++grp) { const float lt = red_sum4(ls[grp]) + __builtin_amdgcn_exp2f(sink[4 * kvh + grp] * LOG2E + negb);
            store_group(O[grp], __builtin_amdgcn_rcpf(lt), Ob + qrow * DM + (4 * kvh + grp) * 64, g); }
    }
}
}

__device__ __forceinline__ float wave_sum(float v) {
#pragma unroll
    for (int o = 1; o < 64; o <<= 1) v += __shfl_xor(v, o);
    return v;
}
__device__ __forceinline__ void transpose_item(const float* W, int K, int N, bf16_t* WT, bool perm, LAS float* scr, int item, int lane) {
    const int nblk = N / 32, kb = item / nblk, nb = item % nblk, k0 = 64 * kb, n0 = 32 * nb;
    const int r0 = perm ? ((n0 & ~255) + 128 * ((n0 >> 5) & 1) + 32 * ((n0 >> 6) & 3)) : n0;
#pragma unroll
    for (int i = 0; i < 32; ++i) { const int kk = 2 * i + (lane >> 5); scr[kk * 33 + (lane & 31)] = W[(size_t)(k0 + kk) * N + n0 + (lane & 31)]; }
    asm volatile("s_waitcnt lgkmcnt(0)" ::: "memory");
    const int c = lane & 7;
#pragma unroll
    for (int j = 0; j < 4; ++j) { const int n = (lane >> 3) + 8 * j; const LAS float* s = scr + (8 * c) * 33 + n;
        u32x4 o; o.x = pkbf(s[0 * 33], s[1 * 33]); o.y = pkbf(s[2 * 33], s[3 * 33]); o.z = pkbf(s[4 * 33], s[5 * 33]); o.w = pkbf(s[6 * 33], s[7 * 33]);
        *(u32x4*)(WT + (size_t)(r0 + n) * K + k0 + 8 * c) = o; }
    asm volatile("s_waitcnt lgkmcnt(0)" ::: "memory");
}

struct Args {
    const float *x, *c, *ctx, *c_ctx, *ada_w, *ada_b, *g_mix, *g_mlp, *mlp_w1, *mlp_w2, *na_wqkv, *na_q_gain, *na_k_gain, *na_rpb, *na_wo,
                *swa_wqkv, *swa_q_gain, *swa_k_gain, *swa_sink, *swa_wo;
    float* out; unsigned char* ws;
};

__device__ __forceinline__ void prologue_phase(const Args& a, LAS unsigned char* lds) {
    const int tid = threadIdx.x, lane = tid & 63, w = __builtin_amdgcn_readfirstlane(tid >> 6);
    float* mods = (float*)(a.ws + WS_MODS);
    if (blockIdx.x < 96) {
        const int l = blockIdx.x / 48, cgp = blockIdx.x % 48; const int j = 128 * cgp + 2 * lane;
        LAS float* sil = (LAS float*)(lds + 32768);
        for (int i = tid; i < 5 * DM; i += 512) { const float cv = i < 4 * DM ? a.c[i] : a.c_ctx[i - 4 * DM]; sil[i] = cv / (1.0f + __expf(-cv)); }
        __syncthreads();
        float acc[5][2];
#pragma unroll
        for (int s = 0; s < 5; ++s) { acc[s][0] = 0.f; acc[s][1] = 0.f; }
        const float* wp = a.ada_w + ((size_t)l * DM + 128 * w) * 6144 + j;
#pragma unroll 8
        for (int kk = 0; kk < 128; ++kk) { const int k = 128 * w + kk; const f32x2_t wv = *(const f32x2_t*)(wp + (size_t)kk * 6144);
#pragma unroll
            for (int s = 0; s < 5; ++s) { const float sv = sil[s * DM + k]; acc[s][0] += sv * wv.x; acc[s][1] += sv * wv.y; } }
        LAS float* part = (LAS float*)lds;
#pragma unroll
        for (int s = 0; s < 5; ++s) { part[(w * 5 + s) * 128 + 2 * lane] = acc[s][0]; part[(w * 5 + s) * 128 + 2 * lane + 1] = acc[s][1]; }
        __syncthreads();
        for (int idx = tid; idx < 640; idx += 512) { const int s = idx >> 7, col = idx & 127; float t = 0.f;
#pragma unroll
            for (int ww = 0; ww < 8; ++ww) t += part[(ww * 5 + s) * 128 + col];
            mods[(l * 5 + s) * 6144 + 128 * cgp + col] = t + a.ada_b[l * 6144 + 128 * cgp + col]; }
        __syncthreads();
    } else if (blockIdx.x == 96) {
        float* rope = (float*)(a.ws + WS_ROPE);
        for (int idx = tid; idx < 2048; idx += 512) { const int pos = idx >> 4, f = idx & 15;
            const float inv = exp2f(-(float)f * (13.287712379549449f / 16.0f)); const float ang = (float)pos * inv;
            float xr = ang * 0.15915494309189535f; xr -= floorf(xr);
            rope[idx] = __builtin_amdgcn_cosf(xr); rope[2048 + idx] = __builtin_amdgcn_sinf(xr); }
        float* gains = (float*)(a.ws + WS_GAINS);
        if (tid < 256) { const int l = tid >> 7, k = (tid >> 6) & 1, d = tid & 63;
            const float* src = l == 0 ? (k == 0 ? a.na_q_gain : a.na_k_gain) : (k == 0 ? a.swa_q_gain : a.swa_k_gain);
            gains[tid] = src[d] * (k == 0 ? QSCALE : 1.0f); }
        if (tid == 0) *(Args*)(a.ws + WS_ARGS) = a;
        float mxb = -1e30f;
        for (int i = tid; i < NHEAD * 465; i += 512) mxb = fmaxf(mxb, a.na_rpb[i]);
#pragma unroll
        for (int o = 1; o < 64; o <<= 1) mxb = fmaxf(mxb, __shfl_xor(mxb, o));
        LAS float* red = (LAS float*)lds;
        if (lane == 0) red[w] = mxb;
        __syncthreads();
        if (w == 0) {
            float g0 = fabsf(a.na_q_gain[lane]), g1 = fabsf(a.na_k_gain[lane]), g2 = fabsf(a.swa_q_gain[lane]), g3 = fabsf(a.swa_k_gain[lane]);
#pragma unroll
            for (int o = 1; o < 64; o <<= 1) { g0 = fmaxf(g0, __shfl_xor(g0, o)); g1 = fmaxf(g1, __shfl_xor(g1, o)); g2 = fmaxf(g2, __shfl_xor(g2, o)); g3 = fmaxf(g3, __shfl_xor(g3, o)); }
            float mb = red[0];
#pragma unroll
            for (int i = 1; i < 8; ++i) mb = fmaxf(mb, red[i]);
            if (lane == 0) { float* bnd = (float*)(a.ws + WS_BND); bnd[0] = (8.0f * g0 * g1 + fmaxf(mb, 0.f)) * LOG2E; bnd[1] = 8.0f * g2 * g3 * LOG2E; }
        }
        __syncthreads();
    }
    LAS float* scr = (LAS float*)(lds + w * 16384);
    const int gw = blockIdx.x * 8 + w, ngw = gridDim.x * 8;
    constexpr int I_QKV0 = 16 * 96, I_WO = 16 * 32, I_QKV1 = 16 * 48, I_W1 = 16 * 128, I_W2 = 64 * 32;
    constexpr int NITEMS = I_QKV0 + 2 * I_WO + I_QKV1 + 2 * I_W1 + 2 * I_W2;
    constexpr int HCAP = 2; const int nfree = ((int)gridDim.x > 96 ? (int)gridDim.x - 96 : 0) * 8, pre = nfree * HCAP < NITEMS ? nfree * HCAP : 0;
    const int fw = ((int)blockIdx.x - 96) * 8 + w;
    for (int k = 0;; ++k) {
        int it;
        if (pre && k < HCAP) { if ((int)blockIdx.x < 96) continue; it = fw + k * nfree; }
        else { it = pre + gw + (k - (pre ? HCAP : 0)) * ngw; if (it >= NITEMS) break; }
        int r = it;
        if (r < I_QKV0) { transpose_item(a.na_wqkv, DM, 3072, (bf16_t*)(a.ws + WS_WQKV0), true, scr, r, lane); continue; } r -= I_QKV0;
        if (r < I_WO) { transpose_item(a.na_wo, DM, DM, (bf16_t*)(a.ws + WS_WO0), false, scr, r, lane); continue; } r -= I_WO;
        if (r < I_QKV1) { transpose_item(a.swa_wqkv, DM, 1536, (bf16_t*)(a.ws + WS_WQKV1), true, scr, r, lane); continue; } r -= I_QKV1;
        if (r < I_WO) { transpose_item(a.swa_wo, DM, DM, (bf16_t*)(a.ws + WS_WO1), false, scr, r, lane); continue; } r -= I_WO;
        if (r < 2 * I_W1) { const int l = r / I_W1; transpose_item(a.mlp_w1 + (size_t)l * DM * DFF, DM, DFF, (bf16_t*)(a.ws + WS_W1) + (size_t)l * DM * DFF, false, scr, r % I_W1, lane); continue; } r -= 2 * I_W1;
        { const int l = r / I_W2; transpose_item(a.mlp_w2 + (size_t)l * DM * DFF, DFF, DM, (bf16_t*)(a.ws + WS_W2) + (size_t)l * DM * DFF, false, scr, r % I_W2, lane); }
    }
}

__device__ __forceinline__ void norm_phase(const void* src_lat, int lat_f32, const float* src_ctx, int nrows, const float* gvec, const float* mods_l, int sh_off, int sc_off, bf16_t* U, const float* part, int nparts, float* ctx_out) {
    int tid_ = threadIdx.x; asm volatile("" : "+v"(tid_));
    const int lane = tid_ & 63, w = __builtin_amdgcn_readfirstlane(tid_ >> 6);
    const int gw = blockIdx.x * 8 + w, ngw = gridDim.x * 8;

    f32x4 gv[4];
#pragma unroll
    for (int j = 0; j < 4; ++j) gv[j] = *(const f32x4*)(gvec + 4 * lane + 256 * j);
    for (int row = gw; row < nrows; row += ngw) {
        const int s = row < MLAT ? (row >> 13) : 4;
        f32x4 v[4]; float ss = 0.f;
        if (row < MLAT && !lat_f32) { const bf16_t* src = (const bf16_t*)src_lat + (size_t)row * DM + 4 * lane;
#pragma unroll
            for (int j = 0; j < 4; ++j) { const u32x2 w = *(const u32x2*)(src + 256 * j);
                v[j] = (f32x4){__uint_as_float(w.x << 16), __uint_as_float(w.x & 0xffff0000u), __uint_as_float(w.y << 16), __uint_as_float(w.y & 0xffff0000u)}; } }
        else { const float* src = row < MLAT ? (const float*)src_lat + (size_t)row * DM : src_ctx + (size_t)(row - MLAT) * DM;
#pragma unroll
            for (int j = 0; j < 4; ++j) v[j] = *(const f32x4*)(src + 4 * lane + 256 * j); }
#pragma unroll
        for (int j = 0; j < 4; ++j) { ss += (v[j][0] * v[j][0] + v[j][1] * v[j][1]) + (v[j][2] * v[j][2] + v[j][3] * v[j][3]); }
        if (nparts != 0 && row >= MLAT) {
            for (int ch = 0; ch < nparts; ch += 4) {
                f32x4 pv[4][4];
#pragma unroll
                for (int c4 = 0; c4 < 4; ++c4) { const float* pr = part + ((size_t)(ch + c4) * MCTX + (row - MLAT)) * DM + 4 * lane;
#pragma unroll
                    for (int j = 0; j < 4; ++j) pv[c4][j] = *(const f32x4*)(pr + 256 * j); }
#pragma unroll
                for (int c4 = 0; c4 < 4; ++c4)
#pragma unroll
                    for (int j = 0; j < 4; ++j) v[j] = v[j] + pv[c4][j]; }
            ss = 0.f;
#pragma unroll
            for (int j = 0; j < 4; ++j) { *(f32x4*)(ctx_out + (size_t)(row - MLAT) * DM + 4 * lane + 256 * j) = v[j]; ss += (v[j][0] * v[j][0] + v[j][1] * v[j][1]) + (v[j][2] * v[j][2] + v[j][3] * v[j][3]); }
        }
        const float rs = rsqrtf(wave_sum64(ss) * (1.0f / DM) + EPS);
        const float* shp = mods_l + s * 6144 + sh_off + 4 * lane; const float* scp = mods_l + s * 6144 + sc_off + 4 * lane;
        bf16_t* up = U + (size_t)row * DM + 4 * lane;
#pragma unroll
        for (int j = 0; j < 4; ++j) { const f32x4 sh = *(const f32x4*)(shp + 256 * j), sc = *(const f32x4*)(scp + 256 * j);
            const f32x4 y = v[j] * rs * gv[j] * (sc + 1.0f) + sh;
            u32x2 o; o.x = pkbf(y[0], y[1]); o.y = pkbf(y[2], y[3]); *(u32x2*)(up + 256 * j) = o; }
    }
}

#define XB_TMO      128
#define XB_XCNT(j)  (256  + 64 * (j))
#define XB_XSUB(j)  (1280 + 64 * (j))
#define XB_XGEN(j)  (2304 + 64 * (j))
#define XB_TOP      3328
#define XB_TOPGEN   3392
#define XCD_BAR_WORDS 3456
#define XB_SPIN_CAP (1u << 18)

__device__ __forceinline__ unsigned xb_ld(unsigned* p)              { return __hip_atomic_load(p, __ATOMIC_RELAXED, __HIP_MEMORY_SCOPE_AGENT); }
__device__ __forceinline__ unsigned xb_add(unsigned* p, unsigned v) { return __hip_atomic_fetch_add(p, v, __ATOMIC_RELAXED, __HIP_MEMORY_SCOPE_AGENT); }
__device__ __forceinline__ unsigned xb_xcc_id() { return (unsigned)__builtin_amdgcn_s_getreg((3 << 11) | 20) & 0xFu; }
#define XB_SPIN(cond, bar) do { unsigned _sp = 0; while (cond) { __builtin_amdgcn_s_sleep(1); \
    if ((++_sp & 255u) == 0u) { if (xb_ld(&(bar)[XB_TMO])) break; if (_sp > XB_SPIN_CAP) { atomicAdd(&(bar)[XB_TMO], 1u); break; } } } } while (0)

struct XcdBarrier {
    unsigned* bar; unsigned x;
    volatile LAS unsigned* st;
};

__device__ __forceinline__ XcdBarrier xcd_barrier_post(unsigned* bar, volatile LAS unsigned* st) {
    XcdBarrier b; b.bar = bar; b.x = xb_xcc_id(); b.st = st;
    if (threadIdx.x == 0) (void)xb_add(&bar[XB_XCNT(b.x)], 1u);
    return b;
}
__device__ __forceinline__ void xcd_barrier_complete(unsigned* bar, unsigned x, unsigned& nloc, unsigned& nx) {
    const unsigned G = gridDim.x * gridDim.y * gridDim.z;
    unsigned sum, cnt, mine, sp = 0u;
    for (;;) {
        sum = 0u; cnt = 0u; mine = 0u;
#pragma unroll
        for (unsigned j = 0; j < 16; ++j) { const unsigned c = xb_ld(&bar[XB_XCNT(j)]); sum += c; cnt += (c > 0u) ? 1u : 0u; mine = (j == x) ? c : mine; }
        if (sum == G) break;
        __builtin_amdgcn_s_sleep(1);
        if ((++sp & 255u) == 0u) { if (xb_ld(&bar[XB_TMO])) break; if (sp > XB_SPIN_CAP) { atomicAdd(&bar[XB_TMO], 1u); break; } }
    }
    nloc = mine > 0u ? mine : 1u; nx = cnt > 0u ? cnt : 1u;
}

__device__ __forceinline__ void xcd_barrier(const XcdBarrier& b) {
    asm volatile("s_waitcnt vmcnt(0)" ::: "memory");
    __syncthreads();
    if (threadIdx.x == 0) {
        unsigned* bar = b.bar;
        __builtin_amdgcn_s_waitcnt(0);
        unsigned nloc = b.st[0], nx = b.st[1];
        if (nloc == 0u) { xcd_barrier_complete(bar, b.x, nloc, nx); b.st[0] = nloc; b.st[1] = nx; }
        const unsigned old = xb_add(&bar[XB_XSUB(b.x)], 1u);
        const unsigned gen = old / nloc;
        if (old + 1u == (gen + 1u) * nloc) {
            __builtin_amdgcn_fence(__ATOMIC_RELEASE, "agent");
            asm volatile("s_waitcnt vmcnt(0)" ::: "memory");
            const unsigned og = xb_add(&bar[XB_TOP], 1u);
            const unsigned tg = og / nx;
            if (og + 1u == (tg + 1u) * nx) xb_add(&bar[XB_TOPGEN], 1u);
            else XB_SPIN(xb_ld(&bar[XB_TOPGEN]) == tg, bar);
            __builtin_amdgcn_fence(__ATOMIC_ACQUIRE, "agent");
            xb_add(&bar[XB_XGEN(b.x)], 1u);
            asm volatile("s_waitcnt vmcnt(0)" ::: "memory");
        } else {
            XB_SPIN(xb_ld(&bar[XB_XGEN(b.x)]) == gen, bar);
            __builtin_amdgcn_fence(__ATOMIC_ACQUIRE, "agent");
            asm volatile("s_waitcnt vmcnt(0)" ::: "memory");
        }
    }
    __syncthreads();
}

constexpr int LDS_BYTES = 147456;
static_assert(att::NA_TAB + 2 * 512 * 4 <= LDS_BYTES, "LDS map");

__global__ void __launch_bounds__(512, 2) fwd_megakernel(Args a) {
    extern __shared__ __attribute__((aligned(16))) unsigned char lds_raw[];
    LAS unsigned char* lds = (LAS unsigned char*)lds_raw;
#define GSYNC() cg::this_grid().sync()
    unsigned char* const ws = a.ws;
    volatile LAS unsigned* xst = (volatile LAS unsigned*)(lds + LDS_BYTES - 16);
    if (threadIdx.x < 4) xst[threadIdx.x] = 0u;
    __syncthreads();
    XcdBarrier xb0 = xcd_barrier_post((unsigned*)(ws + WS_BAR), xst); (void)xb0;
    if ((const void*)a.c == (const void*)a.ws) GSYNC();
    prologue_phase(a, lds);
#define XSYNC() do { XcdBarrier xb_; xb_.bar = (unsigned*)(ws + WS_BAR); xb_.x = xb_xcc_id(); xb_.st = (volatile LAS unsigned*)(lds + LDS_BYTES - 16); xcd_barrier(xb_); } while (0)
    XSYNC();
    const Args* A = (const Args*)(ws + WS_ARGS);
#define WSP(T, off) ((T*)(ws + (off)))
#pragma unroll 1
    for (int l = 0; l < 2; ++l) {
        const int M = l == 0 ? MALL : MLAT;
#ifndef NORM_REP
#define NORM_REP 1
#endif
#pragma unroll 1
        for (int rep = 0; rep < NORM_REP; ++rep) {
        norm_phase(l == 0 ? (const void*)A->x : (const void*)WSP(bf16_t, WS_HB), l == 0, l == 0 ? A->ctx : WSP(float, WS_HC), MALL, A->g_mix + l * DM, WSP(float, WS_MODS) + l * 5 * 6144, 0, 1024, WSP(bf16_t, WS_U), WSP(const float, WS_PART), l == 0 ? 0 : 16, WSP(float, WS_HC));
        XSYNC();
        }
        {
            const int N = l == 0 ? 3072 : 1536;
            pg8::Gemm g{WSP(bf16_t, WS_U), WSP(const bf16_t, l == 0 ? WS_WQKV0 : WS_WQKV1), MALL, N, DM}; pg8::StaticOrder S; S.init(MALL, N, gridDim.x, blockIdx.x);
            EpiQKV E{WSP(bf16_t, WS_Q), (size_t)(WS_K - WS_Q) / 2, l == 0 ? DM : 256, l == 0 ? 4 : 1, WSP(float, WS_GAINS) + l * 128, l == 0 ? nullptr : WSP(const float, WS_ROPE)};
            pg8::gemm_phase<EpiQKV, pg8::StaticOrder, true, true>(lds, g, S, E);
        }
        XSYNC();
#ifndef ATT_REP
#define ATT_REP 1
#endif
#pragma unroll 1
        for (int rep = 0; rep < ATT_REP; ++rep) {
        if (l == 0) att::na_phase(lds, WSP(bf16_t, WS_Q), WSP(bf16_t, WS_K), WSP(bf16_t, WS_V), WSP(bf16_t, WS_O), A->na_rpb, -WSP(const float, WS_BND)[0]);
        else att::swa_phase(lds, WSP(bf16_t, WS_Q), WSP(bf16_t, WS_K), WSP(bf16_t, WS_V), WSP(bf16_t, WS_O), A->swa_sink, -WSP(const float, WS_BND)[1]);
        XSYNC();
        }
        {
            pg8::Gemm g{WSP(bf16_t, WS_O), WSP(const bf16_t, l == 0 ? WS_WO0 : WS_WO1), M, DM, DM}; SplitOrder S; S.init(DM, DM, l == 0 ? 4 : 0, gridDim.x, blockIdx.x);
            EpiRes E{l == 0 ? (const void*)A->x : (const void*)WSP(bf16_t, WS_HB), WSP(float, WS_HC), WSP(bf16_t, WS_HB), WSP(float, WS_HC), WSP(float, WS_MODS) + l * 5 * 6144 + 2048, WSP(float, WS_PART), l == 0, 0};
            pg8::gemm_phase<EpiRes, SplitOrder, true, true>(lds, g, S, E);
        }
        XSYNC();
#pragma unroll 1
        for (int rep = 0; rep < NORM_REP; ++rep) {
        norm_phase(WSP(bf16_t, WS_HB), 0, l == 0 ? A->ctx : WSP(float, WS_HC), M, A->g_mlp + l * DM, WSP(float, WS_MODS) + l * 5 * 6144, 3072, 4096, WSP(bf16_t, WS_U), WSP(const float, WS_PART), l == 0 ? 4 : 0, WSP(float, WS_HC));
        XSYNC();
        }
#ifndef UP_REP
#define UP_REP 1
#endif
#pragma unroll 1
        for (int rep = 0; rep < UP_REP; ++rep) {
        if (rep) XSYNC();
        {
            pg8::Gemm g{WSP(bf16_t, WS_U), WSP(const bf16_t, WS_W1) + (size_t)l * DM * DFF, M, DFF, DM}; pg8::StaticOrder S; S.init(M, DFF, gridDim.x, blockIdx.x);
            EpiRelu2 E{WSP(bf16_t, WS_HMID), DFF};
            pg8::gemm_phase<EpiRelu2, pg8::StaticOrder, true, true>(lds, g, S, E);
        }
        }
        XSYNC();
        {
            pg8::Gemm g{WSP(bf16_t, WS_HMID), WSP(const bf16_t, WS_W2) + (size_t)l * DM * DFF, M, DM, DFF, 1}; SplitOrder S; S.init(DM, DFF, l == 0 ? 16 : 0, gridDim.x, blockIdx.x, true);
            EpiRes E{WSP(bf16_t, WS_HB), WSP(float, WS_HC), l == 0 ? (void*)WSP(bf16_t, WS_HB) : (void*)A->out, WSP(float, WS_HC), WSP(float, WS_MODS) + l * 5 * 6144 + 5120, WSP(float, WS_PART), 0, l == 1};
            pg8::gemm_phase<EpiRes, SplitOrder, true, true>(lds, g, S, E);
        }
        if (l == 0) XSYNC();
    }
#undef WSP
}

extern "C" void kernel_launch(void* const* d_in, const int* in_sizes, int n_in, void* d_out, int out_size, void* d_ws, size_t ws_size, hipStream_t stream) {
    static int grid_blocks = 0;
    if (grid_blocks == 0) {
        if (n_in != 20 || out_size != MLAT * DM || ws_size < WS_END) { fprintf(stderr, "kernel_launch: unexpected shapes (n_in %d out %d ws %zu)\n", n_in, out_size, ws_size); grid_blocks = -1; return; }
        int dev = 0, cus = 0, per_cu = 0;
        hipGetDevice(&dev);
        hipDeviceGetAttribute(&cus, hipDeviceAttributeMultiprocessorCount, dev);
        hipFuncSetAttribute((const void*)fwd_megakernel, hipFuncAttributeMaxDynamicSharedMemorySize, LDS_BYTES);
        hipOccupancyMaxActiveBlocksPerMultiprocessor(&per_cu, (const void*)fwd_megakernel, 512, LDS_BYTES);
        if (per_cu < 1) { fprintf(stderr, "kernel_launch: occupancy query says %d blocks per CU\n", per_cu); per_cu = 1; }
        grid_blocks = cus * per_cu;
    }
    if (grid_blocks < 0) return;
    if (hipMemsetAsync((unsigned char*)d_ws + WS_BAR, 0, XCD_BAR_WORDS * 4, stream) != hipSuccess) { fprintf(stderr, "kernel_launch: hipMemsetAsync of the barrier words failed\n"); return; }
    Args a{};
    const float** ap = (const float**)&a;
    for (int i = 0; i < 20; ++i) ap[i] = (const float*)d_in[i];
    a.out = (float*)d_out; a.ws = (unsigned char*)d_ws;
    void* args[] = {&a};
    hipError_t e = hipLaunchCooperativeKernel((const void*)fwd_megakernel, dim3(grid_blocks), dim3(512), args, LDS_BYTES, stream);
    if (e != hipSuccess) fprintf(stderr, "cooperative launch failed: %s (grid %d)\n", hipGetErrorString(e), grid_blocks);
}
```

```cpp
#include <hip/hip_runtime.h>
#include <hip/hip_cooperative_groups.h>
#include <cstdio>
#include <cstdint>
namespace cg = cooperative_groups;
namespace pg8 {
#define PG8_LAS __attribute__((address_space(3)))
typedef unsigned short bf16_t;
typedef short bf16x8 __attribute__((ext_vector_type(8)));
typedef float f32x4 __attribute__((ext_vector_type(4)));
typedef unsigned u32x4 __attribute__((ext_vector_type(4)));
constexpr int BM = 256, BK = 64, HALF = 128, HTB = HALF * BK * 2  , STAGE_BYTES = 8 * HTB, NXCD = 8, WGM = 8;

__host__ __device__ __forceinline__ int lds_byte(int r, int c) { const int st = (r >> 4) * 2 + (c >> 5), rr = r & 15, cc = c & 31, ob = rr * 64 + cc * 2; return st * 1024 + (ob ^ (((ob >> 9) & 1) << 5)); }
__host__ __device__ __forceinline__ void stage_rc(int b, int& R, int& C) { const int st = b / 1024, sb = b % 1024, swz = sb ^ (((sb >> 9) & 1) << 5); R = (st >> 1) * 16 + swz / 64; C = (st & 1) * 32 + (swz % 64) / 2; }
__host__ __device__ __forceinline__ int perm32(int rho) { const int n = rho >> 4, i = rho & 15; return 8 * (i >> 2) + 4 * n + (i & 3); }

struct Unit { int pm, pn, k0, nt; };
struct Gemm { const bf16_t* A; const bf16_t* Bt; int M, N, K; int krev; };

struct StaticOrder {
    int nM, nN, nwg, G, c;
    __host__ __device__ void init(int M, int N, int G_, int c_) { nM = M / BM; nN = N / BM; nwg = nM * nN; G = G_; c = c_; }
    __host__ __device__ bool next(int i, Unit& u) const {
        const long L = (long)i * G + c; if (L >= nwg) return false;
        int wgid = (int)L; { const int q = nwg / NXCD, r = nwg % NXCD, xcd = wgid % NXCD, off = wgid / NXCD; wgid = (xcd < r ? xcd * (q + 1) : r * (q + 1) + (xcd - r) * q) + off; }
        const int nig = WGM * nN, gid = wgid / nig, fm = gid * WGM, gsz = (nM - fm) < WGM ? (nM - fm) : WGM;
        u.pm = fm + ((wgid % nig) % gsz); u.pn = (wgid % nig) / gsz; u.k0 = 0; u.nt = 0; return true;
    }
    __device__ __forceinline__ void a_ready(const Unit&) const {}
    __device__ __forceinline__ void done(const Unit&) const {}
};

__device__ __forceinline__ unsigned cvt_pk_bf16(float lo, float hi) { unsigned r; asm volatile("v_cvt_pk_bf16_f32 %0, %1, %2" : "=v"(r) : "v"(lo), "v"(hi)); return r; }
template <class Epi, class Sched, bool ALIGN_EPI = false, bool SP2 = false>
__device__ __forceinline__ void gemm_phase(PG8_LAS unsigned char* lds, const Gemm g, const Sched& S, const Epi& E) {
    int tid_ = threadIdx.x; asm volatile("" : "+v"(tid_));
    const int tid = tid_, wid = __builtin_amdgcn_readfirstlane(tid >> 6), lane = tid & 63, wr = wid >> 2, wc = wid & 3, fr = lane & 15, fq = lane >> 4;
    const int K = g.K, ntf = K / BK;
    unsigned voffA[2], voffB[2];
#pragma unroll
    for (int i = 0; i < 2; ++i) { int R, C; stage_rc(tid * 16 + i * 8192, R, C); const int Rb = Epi::PERM ? ((R & ~31) + perm32(R & 31)) : R;
        voffA[i] = (unsigned)(R * K + C) * 2u; voffB[i] = (unsigned)(Rb * K + C) * 2u; }
#define PG8_REV(ui_) (g.krev == 1 || (g.krev == 2 && ((ui_) & 1)))
#define PG8_KOFF(U_, ui_) (PG8_REV(ui_) ? (size_t)(((U_).nt ? (U_).nt : ntf) - 1) * (size_t)(BK * 2) : (size_t)0)
    const size_t kfwd = (size_t)(BK * 2), kbwd = (size_t)0 - (size_t)(BK * 2);
    size_t kstep = PG8_REV(0) ? kbwd : kfwd;
    const size_t hstep = (size_t)HALF * K * 2;
    const size_t tstep = 2 * hstep;
    const unsigned ldsw = (unsigned)wid * 1024u;
    const int aoff = lds_byte(wr * 64 + fr, fq * 8), boff = lds_byte(wc * 32 + fr, fq * 8);
#define PG8_SA(b, h) (((b) * 2 + (h)) * HTB)
#define PG8_SB(b, h) ((4 + (b) * 2 + (h)) * HTB)
#define PG8_STAGE(bufoff, gbase, voff) do { _Pragma("unroll") for (int _i = 0; _i < 2; ++_i) \
        __builtin_amdgcn_global_load_lds((const unsigned*)((const char*)(gbase) + (voff)[_i]), (PG8_LAS unsigned*)(lds + (bufoff) + ldsw + _i * 8192), 16, 0, 0); } while (0)
#define PG8_LDA(dst, b, h) do { _Pragma("unroll") for (int m = 0; m < 4; ++m) _Pragma("unroll") for (int k = 0; k < 2; ++k) dst[m][k] = *(const PG8_LAS bf16x8*)(lds + PG8_SA(b, h) + aoff + m * 2048 + k * 1024); } while (0)
#define PG8_LDB(dst, b, h) do { _Pragma("unroll") for (int n = 0; n < 2; ++n) _Pragma("unroll") for (int k = 0; k < 2; ++k) dst[n][k] = *(const PG8_LAS bf16x8*)(lds + PG8_SB(b, h) + boff + n * 2048 + k * 1024); } while (0)
#define PG8_MMA(ai, bj, At, Bt) do { __builtin_amdgcn_s_setprio(1); _Pragma("unroll") for (int m = 0; m < 4; ++m) _Pragma("unroll") for (int n = 0; n < 2; ++n) _Pragma("unroll") for (int k = 0; k < 2; ++k) \
        acc[ai][bj][m][n] = __builtin_amdgcn_mfma_f32_16x16x32_bf16(Bt[n][k], At[m][k], acc[ai][bj][m][n], 0, 0, 0); __builtin_amdgcn_s_setprio(0); } while (0)
#define PG8_WAIT_V(n) asm volatile("s_waitcnt vmcnt(" #n ")" ::: "memory")
#define PG8_WAIT_L(n) asm volatile("s_waitcnt lgkmcnt(" #n ")" ::: "memory")
#define PG8_BAR __builtin_amdgcn_s_barrier()
#define PG8_SCHED __builtin_amdgcn_sched_barrier(0)
    Unit cur, nxt; int ui = 0;
    if (!S.next(0, cur)) return;
    f32x4 acc[2][2][4][2];
#pragma unroll
    for (int a = 0; a < 2; ++a)
#pragma unroll
        for (int b = 0; b < 2; ++b)
#pragma unroll
            for (int m = 0; m < 4; ++m)
#pragma unroll
                for (int n = 0; n < 2; ++n) acc[a][b][m][n] = (f32x4){0.f, 0.f, 0.f, 0.f};
    bf16x8 At[4][2], B0[2][2], B1[2][2];
    const char* cA = (const char*)g.A + (size_t)cur.pm * tstep + (size_t)cur.k0 * 2 + PG8_KOFF(cur, 0); const char* cB = (const char*)g.Bt + (size_t)cur.pn * tstep + (size_t)cur.k0 * 2 + PG8_KOFF(cur, 0);
    S.a_ready(cur);
    if constexpr (SP2) {
        PG8_STAGE(PG8_SB(0, 0), cB, voffB); PG8_STAGE(PG8_SB(0, 1), cB + hstep, voffB); PG8_STAGE(PG8_SA(0, 0), cA, voffA); PG8_STAGE(PG8_SA(0, 1), cA + hstep, voffA);
        if (wr == 1) PG8_BAR;
        PG8_WAIT_V(2); PG8_BAR;
        PG8_STAGE(PG8_SB(1, 0), cB + kstep, voffB); PG8_STAGE(PG8_SA(1, 0), cA + kstep, voffA); PG8_STAGE(PG8_SB(1, 1), cB + hstep + kstep, voffB);
        PG8_WAIT_V(6); PG8_BAR;
    } else {
        PG8_STAGE(PG8_SB(0, 0), cB, voffB); PG8_STAGE(PG8_SA(0, 0), cA, voffA); PG8_STAGE(PG8_SB(0, 1), cB + hstep, voffB); PG8_STAGE(PG8_SA(0, 1), cA + hstep, voffA);
        if (wr == 1) PG8_BAR;
        PG8_WAIT_V(4); PG8_BAR;
        PG8_STAGE(PG8_SB(1, 0), cB + kstep, voffB); PG8_STAGE(PG8_SA(1, 0), cA + kstep, voffA); PG8_STAGE(PG8_SB(1, 1), cB + hstep + kstep, voffB);
        PG8_WAIT_V(6); PG8_BAR;
    }
    for (;;) {
        const bool has_next = S.next(ui + 1, nxt);
        const char* nA = has_next ? (const char*)g.A + (size_t)nxt.pm * tstep + (size_t)nxt.k0 * 2 + PG8_KOFF(nxt, ui + 1) : cA; const char* nB = has_next ? (const char*)g.Bt + (size_t)nxt.pn * tstep + (size_t)nxt.k0 * 2 + PG8_KOFF(nxt, ui + 1) : cB;
        const size_t knext = has_next ? (PG8_REV(ui + 1) ? kbwd : kfwd) : kstep;
        const int nt = cur.nt ? cur.nt : ntf;
        for (int t = 0; t < nt; t += 2) {
            const bool last = (t == nt - 2);
            const char* a1 = cA + (size_t)(t + 1) * kstep;
            const char* a2 = last ? nA : cA + (size_t)(t + 2) * kstep; const char* b2 = last ? nB : cB + (size_t)(t + 2) * kstep;
            const char* a3 = a2 + (last ? knext : kstep); const char* b3 = b2 + (last ? knext : kstep);
            if (last && has_next) S.a_ready(nxt);
            if constexpr (SP2) {
            PG8_LDB(B0, 0, 0); PG8_LDB(B1, 0, 1); PG8_SCHED; PG8_LDA(At, 0, 0); PG8_STAGE(PG8_SA(1, 1), a1 + hstep, voffA);
            PG8_WAIT_V(8); PG8_WAIT_L(0); PG8_BAR; PG8_MMA(0, 0, At, B0); PG8_MMA(0, 1, At, B1); PG8_BAR; PG8_SCHED;
            PG8_LDA(At, 0, 1); PG8_STAGE(PG8_SB(0, 0), b2, voffB); PG8_STAGE(PG8_SB(0, 1), b2 + hstep, voffB); PG8_STAGE(PG8_SA(0, 0), a2, voffA);
            PG8_WAIT_V(8); PG8_WAIT_L(0); PG8_BAR; PG8_MMA(1, 0, At, B0); PG8_MMA(1, 1, At, B1); PG8_BAR; PG8_SCHED;
            PG8_LDB(B0, 1, 0); PG8_LDB(B1, 1, 1); PG8_SCHED; PG8_LDA(At, 1, 0); PG8_STAGE(PG8_SA(0, 1), a2 + hstep, voffA);
            PG8_WAIT_V(8); PG8_WAIT_L(0); PG8_BAR; PG8_MMA(0, 0, At, B0); PG8_MMA(0, 1, At, B1); PG8_BAR; PG8_SCHED;
            PG8_LDA(At, 1, 1); PG8_STAGE(PG8_SB(1, 0), b3, voffB); PG8_STAGE(PG8_SB(1, 1), b3 + hstep, voffB); PG8_STAGE(PG8_SA(1, 0), a3, voffA);
            PG8_WAIT_V(8); PG8_WAIT_L(0); PG8_BAR; PG8_MMA(1, 0, At, B0); PG8_MMA(1, 1, At, B1); PG8_BAR; PG8_SCHED;
            } else {
            PG8_LDB(B0, 0, 0); PG8_SCHED; PG8_LDA(At, 0, 0); PG8_STAGE(PG8_SA(1, 1), a1 + hstep, voffA);
            PG8_WAIT_L(8); PG8_BAR; PG8_WAIT_L(0); PG8_MMA(0, 0, At, B0); PG8_BAR; PG8_SCHED;
            PG8_LDB(B1, 0, 1); PG8_STAGE(PG8_SB(0, 0), b2, voffB);
            PG8_BAR; PG8_WAIT_L(0); PG8_MMA(0, 1, At, B1); PG8_BAR;
            PG8_LDA(At, 0, 1); PG8_STAGE(PG8_SA(0, 0), a2, voffA);
            PG8_BAR; PG8_WAIT_L(0); PG8_MMA(1, 0, At, B0); PG8_BAR; PG8_SCHED;
            PG8_STAGE(PG8_SB(0, 1), b2 + hstep, voffB);
            PG8_WAIT_V(6); PG8_BAR; PG8_MMA(1, 1, At, B1); PG8_BAR;
            PG8_LDB(B0, 1, 0); PG8_SCHED; PG8_LDA(At, 1, 0); PG8_STAGE(PG8_SA(0, 1), a2 + hstep, voffA);
            PG8_WAIT_L(8); PG8_BAR; PG8_WAIT_L(0); PG8_MMA(0, 0, At, B0); PG8_BAR; PG8_SCHED;
            PG8_LDB(B1, 1, 1); PG8_STAGE(PG8_SB(1, 0), b3, voffB);
            PG8_BAR; PG8_WAIT_L(0); PG8_MMA(0, 1, At, B1); PG8_BAR;
            PG8_LDA(At, 1, 1); PG8_STAGE(PG8_SA(1, 0), a3, voffA);
            PG8_BAR; PG8_WAIT_L(0); PG8_MMA(1, 0, At, B0); PG8_BAR; PG8_SCHED;
            PG8_STAGE(PG8_SB(1, 1), b3 + hstep, voffB);
            PG8_WAIT_V(6); PG8_BAR; PG8_MMA(1, 1, At, B1); PG8_BAR;
            }
        }
        if constexpr (ALIGN_EPI) { if (wr == 0) PG8_BAR; }
        if constexpr (!Epi::AFTER_DRAIN) { E(acc, cur, wr, wc, fr, fq); S.done(cur); }
        if (!has_next) break;
#pragma unroll
        for (int a = 0; a < 2; ++a)
#pragma unroll
            for (int b = 0; b < 2; ++b)
#pragma unroll
                for (int m = 0; m < 4; ++m)
#pragma unroll
                    for (int n = 0; n < 2; ++n) acc[a][b][m][n] = (f32x4){0.f, 0.f, 0.f, 0.f};
        cur = nxt; cA = nA; cB = nB; ++ui; kstep = knext;
        if constexpr (ALIGN_EPI) { if (wr == 1) PG8_BAR; }
    }
    PG8_WAIT_V(0);
    if constexpr (!ALIGN_EPI) { if (wr == 0) PG8_BAR; }
    PG8_BAR;
    if constexpr (Epi::AFTER_DRAIN) { E.fused(acc, cur, wr, wc, fr, fq, lds, wid, lane); S.done(cur); }
#undef PG8_SA
#undef PG8_SB
#undef PG8_STAGE
#undef PG8_LDA
#undef PG8_LDB
#undef PG8_MMA
#undef PG8_WAIT_V
#undef PG8_WAIT_L
#undef PG8_BAR
#undef PG8_SCHED
}
}

#define LAS __attribute__((address_space(3)))
constexpr int NB = 4, SEQ = 8192, DM = 1024, NCTX = 256, NHEAD = 16, DFF = 4096;
constexpr int MLAT = NB * SEQ;
constexpr int MCTX = NB * NCTX;
constexpr int MALL = MLAT + MCTX;
constexpr float EPS = 1e-6f;
constexpr float LOG2E = 1.4426950408889634f;
constexpr float QSCALE = 0.125f * LOG2E;
constexpr float NEGBIG = -1e30f;

constexpr size_t MiB = 1u << 20;
constexpr size_t WS_MODS = 1 * MiB;
constexpr size_t WS_ROPE = 1 * MiB + 512 * 1024;
constexpr size_t WS_GAINS = 1 * MiB + 768 * 1024;
constexpr size_t WS_BND = 1 * MiB + 896 * 1024;
constexpr size_t WS_BAR = 64 * 1024;
constexpr size_t WS_ARGS = 0;
constexpr size_t WS_WQKV0 = 2 * MiB, WS_WO0 = 8 * MiB, WS_WQKV1 = 10 * MiB, WS_WO1 = 13 * MiB, WS_W1 = 16 * MiB, WS_W2 = 32 * MiB;
constexpr size_t WS_HC = 48 * MiB;
constexpr size_t WS_U = 52 * MiB;
constexpr size_t WS_Q = 118 * MiB, WS_K = 184 * MiB, WS_V = 250 * MiB, WS_O = 316 * MiB;
constexpr size_t WS_HMID = 118 * MiB;
constexpr size_t WS_PART = 382 * MiB;
constexpr size_t WS_HB = 446 * MiB;
constexpr size_t WS_END = 510 * MiB;

typedef pg8::f32x4 f32x4;
typedef pg8::bf16x8 bf16x8;
typedef unsigned short bf16_t;
typedef unsigned u32x4 __attribute__((ext_vector_type(4)));
typedef unsigned u32x2 __attribute__((ext_vector_type(2)));
typedef float f32x2_t __attribute__((ext_vector_type(2)));
typedef __bf16 bf16x2_t __attribute__((ext_vector_type(2)));
typedef short s16x4 __attribute__((ext_vector_type(4)));
__device__ __forceinline__ unsigned pkbf(float lo, float hi) { f32x2_t v = {lo, hi}; bf16x2_t b = __builtin_convertvector(v, bf16x2_t); return __builtin_bit_cast(unsigned, b); }

template <int CTRL> __device__ __forceinline__ float dppf(float v) { return __uint_as_float((unsigned)__builtin_amdgcn_update_dpp(0, (int)__float_as_uint(v), CTRL, 0xF, 0xF, true)); }
__device__ __forceinline__ float xsum4(float v) {
    auto a = __builtin_amdgcn_permlane16_swap(__float_as_uint(v), __float_as_uint(v), false, false);
    v = __uint_as_float(a[0]) + __uint_as_float(a[1]);
    auto b = __builtin_amdgcn_permlane32_swap(__float_as_uint(v), __float_as_uint(v), false, false);
    return __uint_as_float(b[0]) + __uint_as_float(b[1]);
}
__device__ __forceinline__ float wave_sum64(float v) {
    v += dppf<0xB1>(v); v += dppf<0x4E>(v); v += dppf<0x141>(v); v += dppf<0x140>(v);
    return xsum4(v);
}

struct EpiRelu2 {
    static constexpr bool PERM = true, AFTER_DRAIN = false;
    bf16_t* O; int ldc;
    __device__ __forceinline__ void operator()(const f32x4 (&acc)[2][2][4][2], const pg8::Unit& u, int wr, int wc, int fr, int fq) const {
        const int row0 = u.pm * 256 + wr * 64 + fr, col0 = u.pn * 256 + wc * 32 + 8 * fq;
#pragma unroll
        for (int ai = 0; ai < 2; ++ai)
#pragma unroll
            for (int m = 0; m < 4; ++m) { bf16_t* rowp = O + (size_t)(row0 + ai * 128 + m * 16) * ldc + col0;
#pragma unroll
                for (int bj = 0; bj < 2; ++bj) { f32x4 v0 = acc[ai][bj][m][0], v1 = acc[ai][bj][m][1];
#pragma unroll
                    for (int i = 0; i < 4; ++i) { float a = fmaxf(v0[i], 0.f), b = fmaxf(v1[i], 0.f); v0[i] = a * a; v1[i] = b * b; }
                    u32x4 w; w.x = pkbf(v0[0], v0[1]); w.y = pkbf(v0[2], v0[3]); w.z = pkbf(v1[0], v1[1]); w.w = pkbf(v1[2], v1[3]);
                    *(u32x4*)(rowp + bj * 128) = w; } }
    }
};
struct SplitOrder {
    pg8::StaticOrder lat; int S, ntc, nr;
    __device__ void init(int N, int K, int S_, int G_, int c_, bool rev = false) { lat.init(MLAT, N, G_, c_); S = S_; ntc = S_ ? K / 64 / S_ : 0; nr = (rev && lat.nwg % G_ == 0) ? lat.nwg / G_ : 0; }
    __device__ bool next(int i, pg8::Unit& u) const {
        if (nr > 0 && i < nr) return lat.next(nr - 1 - i, u);
        if (lat.next(i, u)) return true;
        const int j = i * lat.G + lat.c - lat.nwg; if (j >= 16 * S) return false;
        const int tile = j / S, ch = j - tile * S; u.pm = 128 + (tile >> 2); u.pn = tile & 3; u.k0 = ch * ntc * 64; u.nt = ntc; return true;
    }
    __device__ __forceinline__ void a_ready(const pg8::Unit&) const {}
    __device__ __forceinline__ void done(const pg8::Unit&) const {}
};
struct EpiRes {
    static constexpr bool PERM = true, AFTER_DRAIN = false;
    const void* base_lat; const float* base_ctx; void* out_lat; float* out_ctx; const float* gate; float* part; int base_f32, out_f32;
    __device__ __forceinline__ void operator()(const f32x4 (&acc)[2][2][4][2], const pg8::Unit& u, int wr, int wc, int fr, int fq) const {
        const bool isctx = u.pm >= 128; const int s = isctx ? 4 : (u.pm >> 5);
        const int col0 = u.pn * 256 + wc * 32 + 8 * fq;
        const float* gp = gate + s * 6144 + col0;
        int row0 = (isctx ? u.pm - 128 : u.pm) * 256 + wr * 64 + fr; asm volatile("" : "+v"(row0));
        f32x4 g[2][2];
#pragma unroll
        for (int bj = 0; bj < 2; ++bj) { g[bj][0] = *(const f32x4*)(gp + bj * 128); g[bj][1] = *(const f32x4*)(gp + bj * 128 + 4); }
        if (u.nt != 0) {
            float* pp = part + (size_t)(u.k0 / (u.nt * 64)) * MCTX * DM;
#pragma unroll
            for (int ai = 0; ai < 2; ++ai)
#pragma unroll
                for (int m = 0; m < 4; ++m) { float* o = pp + (size_t)(row0 + ai * 128 + m * 16) * DM + col0;
#pragma unroll
                    for (int bj = 0; bj < 2; ++bj)
#pragma unroll
                        for (int n = 0; n < 2; ++n) *(f32x4*)(o + bj * 128 + 4 * n) = g[bj][n] * acc[ai][bj][m][n]; }
            return;
        }
        const bool bf = isctx || base_f32, of = isctx || out_f32;
        const float* bpf = isctx ? base_ctx : (const float*)base_lat; float* opf = isctx ? out_ctx : (float*)out_lat;
        const bf16_t* bph = (const bf16_t*)base_lat; bf16_t* oph = (bf16_t*)out_lat;
#pragma unroll
        for (int ai = 0; ai < 2; ++ai)
#pragma unroll
            for (int m = 0; m < 4; ++m) { const size_t off = (size_t)(row0 + ai * 128 + m * 16) * DM + col0;
#pragma unroll
                for (int bj = 0; bj < 2; ++bj) {
                    f32x4 b0, b1;
                    if (bf) { b0 = *(const f32x4*)(bpf + off + bj * 128); b1 = *(const f32x4*)(bpf + off + bj * 128 + 4); }
                    else { const u32x4 w = *(const u32x4*)(bph + off + bj * 128);
                        b0 = (f32x4){__uint_as_float(w.x << 16), __uint_as_float(w.x & 0xffff0000u), __uint_as_float(w.y << 16), __uint_as_float(w.y & 0xffff0000u)};
                        b1 = (f32x4){__uint_as_float(w.z << 16), __uint_as_float(w.z & 0xffff0000u), __uint_as_float(w.w << 16), __uint_as_float(w.w & 0xffff0000u)}; }
                    const f32x4 o0 = b0 + g[bj][0] * acc[ai][bj][m][0], o1 = b1 + g[bj][1] * acc[ai][bj][m][1];
                    if (of) { *(f32x4*)(opf + off + bj * 128) = o0; *(f32x4*)(opf + off + bj * 128 + 4) = o1; }
                    else { u32x4 w; w.x = pkbf(o0[0], o0[1]); w.y = pkbf(o0[2], o0[3]); w.z = pkbf(o1[0], o1[1]); w.w = pkbf(o1[2], o1[3]); *(u32x4*)(oph + off + bj * 128) = w; } } }
    }
};
struct EpiQKV {
    static constexpr bool PERM = true, AFTER_DRAIN = false;
    bf16_t* Q; size_t kstride; int kvpitch; int nk_tiles;
    const float* gains; const float* rope;
    __device__ __forceinline__ void operator()(const f32x4 (&acc)[2][2][4][2], const pg8::Unit& u, int wr, int wc, int fr, int fq) const {
        const int pn = u.pn; const int kind = pn < 4 ? 0 : (pn < 4 + nk_tiles ? 1 : 2);
        const int hd = (kind == 0 ? pn : (kind == 1 ? pn - 4 : pn - 4 - nk_tiles)) * 4 + wc;
        bf16_t* dst = Q + (size_t)kind * kstride + hd * 64 + 8 * fq; const int pitch = kind == 0 ? DM : kvpitch;
        const float* gp = gains + (kind & 1) * 64 + 8 * fq;
        const bool dorope = (rope != nullptr) && kind < 2 && u.pm < 128;
        const float* rp = rope + 8 * (fq & 1);
        int rbase = u.pm * 256 + wr * 64 + fr; asm volatile("" : "+v"(rbase));
        const int paddr = ((fr + 16 * fq) ^ 32) << 2;
#pragma unroll
        for (int ai = 0; ai < 2; ++ai)
#pragma unroll
            for (int m = 0; m < 4; ++m) {
                const int row = rbase + ai * 128 + m * 16;
                float rs = 1.0f;
                if (kind < 2) {
                    float ss = 0.f;
#pragma unroll
                    for (int bj = 0; bj < 2; ++bj)
#pragma unroll
                        for (int n = 0; n < 2; ++n) { const f32x4 x = acc[ai][bj][m][n]; ss += (x[0] * x[0] + x[1] * x[1]) + (x[2] * x[2] + x[3] * x[3]); }
                    ss = xsum4(ss);
                    rs = rsqrtf(ss * (1.0f / 64.0f) + EPS);
                }
                const int t = row & (SEQ - 1);
#pragma unroll
                for (int bj = 0; bj < 2; ++bj) {
                    f32x4 v0 = acc[ai][bj][m][0], v1 = acc[ai][bj][m][1];
                    if (kind < 2) {
                        v0 = v0 * rs * *(const f32x4*)(gp + 32 * bj); v1 = v1 * rs * *(const f32x4*)(gp + 32 * bj + 4);
                        if (dorope) {
                            const int pos = bj ? (t & 63) : (t >> 6);
                            const f32x4 c0 = *(const f32x4*)(rp + pos * 16), c1 = *(const f32x4*)(rp + pos * 16 + 4);
                            const f32x4 s0 = *(const f32x4*)(rp + 2048 + pos * 16), s1 = *(const f32x4*)(rp + 2048 + pos * 16 + 4);
                            f32x4 o0, o1;
#pragma unroll
                            for (int i = 0; i < 4; ++i) { const float p0 = __uint_as_float((unsigned)__builtin_amdgcn_ds_bpermute(paddr, (int)__float_as_uint(v0[i]))) * s0[i], p1 = __uint_as_float((unsigned)__builtin_amdgcn_ds_bpermute(paddr, (int)__float_as_uint(v1[i]))) * s1[i];
                                o0[i] = v0[i] * c0[i] + (fq >= 2 ? p0 : -p0); o1[i] = v1[i] * c1[i] + (fq >= 2 ? p1 : -p1); }
                            v0 = o0; v1 = o1;
                        }
                    }
                    u32x4 w; w.x = pkbf(v0[0], v0[1]); w.y = pkbf(v0[2], v0[3]); w.z = pkbf(v1[0], v1[1]); w.w = pkbf(v1[2], v1[3]);
                    *(u32x4*)(dst + (size_t)row * pitch + 32 * bj) = w;
                }
                asm volatile("" ::: "memory");
            }
    }
};

namespace att {
#define DMA_SYNC() do { asm volatile("s_waitcnt vmcnt(0)" ::: "memory"); __syncthreads(); } while (0)
__device__ __forceinline__ float red_max4(float v) {
    auto a = __builtin_amdgcn_permlane16_swap(__float_as_uint(v), __float_as_uint(v), false, false);
    v = fmaxf(__uint_as_float(a[0]), __uint_as_float(a[1]));
    auto b = __builtin_amdgcn_permlane32_swap(__float_as_uint(v), __float_as_uint(v), false, false);
    return fmaxf(__uint_as_float(b[0]), __uint_as_float(b[1]));
}
__device__ __forceinline__ float red_sum4(float v) {
    auto a = __builtin_amdgcn_permlane16_swap(__float_as_uint(v), __float_as_uint(v), false, false);
    v = __uint_as_float(a[0]) + __uint_as_float(a[1]);
    auto b = __builtin_amdgcn_permlane32_swap(__float_as_uint(v), __float_as_uint(v), false, false);
    return __uint_as_float(b[0]) + __uint_as_float(b[1]);
}
typedef short v4i16_t __attribute__((ext_vector_type(4)));
__device__ __forceinline__ s16x4 vtr(const LAS unsigned char* p) { return __builtin_bit_cast(s16x4, __builtin_amdgcn_ds_read_tr16_b64_v4i16((LAS v4i16_t*)p)); }
__device__ __forceinline__ bf16x8 cat8(s16x4 a, s16x4 b) { return (bf16x8){a[0], a[1], a[2], a[3], b[0], b[1], b[2], b[3]}; }
__device__ __forceinline__ bf16x8 pack8(const f32x4& a, const f32x4& b) { u32x4 w; w.x = pkbf(a[0], a[1]); w.y = pkbf(a[2], a[3]); w.z = pkbf(b[0], b[1]); w.w = pkbf(b[2], b[3]); return __builtin_bit_cast(bf16x8, w); }

struct DmaLane { unsigned koff, voff; };
__device__ __forceinline__ DmaLane dma_lane(int pitch, int col0, int w, int lane) {
    const int key = 8 * w + (lane >> 3), slot = lane & 7;
    const int c8k = slot ^ (key & 7), c8v = (((slot >> 1) ^ ((key >> 1) & 3)) << 1) | (slot & 1);
    DmaLane d; d.koff = (unsigned)((key * pitch + col0 + c8k * 8) * 2); d.voff = (unsigned)((key * pitch + col0 + c8v * 8) * 2); return d;
}
__device__ __forceinline__ void glds16(const unsigned char* sbase, unsigned voff, unsigned lds_dst) { unsigned keep;
    asm volatile("s_mov_b32 %0, m0\n\ts_mov_b32 m0, %3\n\ts_nop 0\n\tglobal_load_lds_dwordx4 %1, %2\n\ts_mov_b32 m0, %0" : "=&s"(keep) : "v"(voff), "s"(sbase), "s"(lds_dst) : "memory"); }
template <int NHT> __device__ __forceinline__ void dma_tile(LAS unsigned char* buf, const bf16_t* Kg, const bf16_t* Vg, size_t row0, int pitch, const DmaLane& d, int w) {
    const unsigned char* kb = (const unsigned char*)Kg + row0 * (size_t)pitch * 2; const unsigned char* vb = (const unsigned char*)Vg + row0 * (size_t)pitch * 2;
    const unsigned l0 = (unsigned)__builtin_amdgcn_readfirstlane((int)(unsigned)(uintptr_t)buf + w * 1024);
#pragma unroll
    for (int hh = 0; hh < NHT; ++hh) {
        glds16(kb, d.koff + hh * 128, l0 + hh * 8192);
        glds16(vb, d.voff + hh * 128, l0 + NHT * 8192 + hh * 8192); }
}

template <int NB16> __device__ __forceinline__ float exp_step(f32x4 (&S)[NB16]) {
    float sum = 0.f;
#pragma unroll
    for (int k = 0; k < NB16; ++k)
#pragma unroll
        for (int i = 0; i < 4; ++i) { S[k][i] = __builtin_amdgcn_exp2f(S[k][i]); sum += S[k][i]; }
    return sum;
}

template <int MASK, int GPB, int SB = 1> __device__ __forceinline__ void full_tile(f32x4 (&O)[4][4], float (&ls)[4], const bf16x8 (&qf)[4][2], float negb,
                                                            const LAS unsigned char* Kt, const LAS unsigned char* Vt, int lane, int rel0) {
    const int l15 = lane & 15, g = lane >> 4, q4 = l15 >> 2;
    const LAS unsigned char* kb0 = Kt + l15 * 128;
    const int kx0 = ((g) ^ (l15 & 7)) << 4, kx1 = ((4 + g) ^ (l15 & 7)) << 4;
    const LAS unsigned char* vrow = Vt + (4 * g + q4) * 128 + (lane & 3) * 8;
    const int swz = (2 * (g & 1) + (q4 >> 1)) & 3;
    const f32x4 cinit = (f32x4){negb, negb, negb, negb};
#pragma unroll
    for (int gh = 0; gh < 4 / GPB; ++gh) {
        f32x4 S[GPB][4];
#pragma unroll
        for (int kb = 0; kb < 4; ++kb) {
            const bf16x8 kf0 = *(const LAS bf16x8*)(kb0 + (16 * kb) * 128 + kx0), kf1 = *(const LAS bf16x8*)(kb0 + (16 * kb) * 128 + kx1);
#pragma unroll
            for (int gi = 0; gi < GPB; ++gi) { S[gi][kb] = __builtin_amdgcn_mfma_f32_16x16x32_bf16(kf0, qf[GPB * gh + gi][0], cinit, 0, 0, 0);
                S[gi][kb] = __builtin_amdgcn_mfma_f32_16x16x32_bf16(kf1, qf[GPB * gh + gi][1], S[gi][kb], 0, 0, 0); } }
        bf16x8 pf[GPB][2];
#pragma unroll
        for (int gi = 0; gi < GPB; ++gi) {
            if (MASK) {
#pragma unroll
                for (int kb = 0; kb < 4; ++kb)
#pragma unroll
                    for (int i = 0; i < 4; ++i) { const int rel = rel0 + 16 * kb + 4 * g + i; S[gi][kb][i] = ((unsigned)(rel + 128) > 256u) ? NEGBIG : S[gi][kb][i]; }
            }
            ls[GPB * gh + gi] += exp_step<4>(S[gi]);
            pf[gi][0] = pack8(S[gi][0], S[gi][1]); pf[gi][1] = pack8(S[gi][2], S[gi][3]);
        }
#pragma unroll
        for (int kc = 0; kc < 2; ++kc)
#pragma unroll
            for (int db = 0; db < 4; ++db) {
                const LAS unsigned char* va = vrow + ((db ^ swz) << 5) + (32 * kc) * 128;
                const bf16x8 vf = cat8(vtr(va), vtr(va + 16 * 128));
#pragma unroll
                for (int gi = 0; gi < GPB; ++gi) O[GPB * gh + gi][db] = __builtin_amdgcn_mfma_f32_16x16x32_bf16(vf, pf[gi][kc], O[GPB * gh + gi][db], 0, 0, 0);
            }
        if (SB == 1) __builtin_amdgcn_sched_barrier(0); else if (SB == 2) __builtin_amdgcn_sched_barrier(0x108);
    }
}

__device__ __forceinline__ void na_local_tile(f32x4 (&O)[4][4], float (&ls)[4], const bf16x8 (&qf)[4][2], float negb,
                                              const LAS unsigned char* Kt, const LAS unsigned char* Vt, int lane, const LAS float* bias_row, bool rowvalid) {
    const int l15 = lane & 15, g = lane >> 4, q4 = l15 >> 2;
    const LAS unsigned char* kb0 = Kt + l15 * 128;
    const int kx0 = ((g) ^ (l15 & 7)) << 4, kx1 = ((4 + g) ^ (l15 & 7)) << 4;
    const LAS unsigned char* vrow = Vt + (4 * g + q4) * 128 + (lane & 3) * 8;
    const int swz = (2 * (g & 1) + (q4 >> 1)) & 3;
#pragma unroll
    for (int grp = 0; grp < 4; ++grp) {
        const int kwin = grp == 0 ? 0 : (grp == 1 ? 8 : (grp == 2 ? 24 : 32));
        f32x4 S[2];
#pragma unroll
        for (int k2 = 0; k2 < 2; ++k2) {
            const bf16x8 kf0 = *(const LAS bf16x8*)(kb0 + (kwin + 16 * k2) * 128 + kx0), kf1 = *(const LAS bf16x8*)(kb0 + (kwin + 16 * k2) * 128 + kx1);
            S[k2] = __builtin_amdgcn_mfma_f32_16x16x32_bf16(kf0, qf[grp][0], (f32x4){negb, negb, negb, negb}, 0, 0, 0);
            S[k2] = __builtin_amdgcn_mfma_f32_16x16x32_bf16(kf1, qf[grp][1], S[k2], 0, 0, 0); }
        const int c = 16 * grp + l15; const int c0 = rowvalid ? min(max(c - 8, 0), 48) : 4096;
        const LAS float* bl = bias_row + (15 - c + 4 * g);
#pragma unroll
        for (int k2 = 0; k2 < 2; ++k2)
#pragma unroll
            for (int i = 0; i < 4; ++i) { const int kc = kwin + 16 * k2 + 4 * g + i; const float bias = bl[kwin + 16 * k2 + i];
                S[k2][i] = ((unsigned)(kc - c0) < 16u) ? S[k2][i] + bias : NEGBIG; }
        ls[grp] += exp_step<2>(S);
        const bf16x8 pf = pack8(S[0], S[1]);
#pragma unroll
        for (int db = 0; db < 4; ++db) {
            const LAS unsigned char* va = vrow + ((db ^ swz) << 5) + kwin * 128;
            const bf16x8 vf = cat8(vtr(va), vtr(va + 16 * 128));
            O[grp][db] = __builtin_amdgcn_mfma_f32_16x16x32_bf16(vf, pf, O[grp][db], 0, 0, 0);
        }
        __builtin_amdgcn_sched_barrier(0x108);
    }
}

__device__ __forceinline__ void store_group(const f32x4 (&Og)[4], float inv, bf16_t* orow, int g) {
#pragma unroll
    for (int db = 0; db < 4; ++db) { u32x2 w; w.x = pkbf(Og[db][0] * inv, Og[db][1] * inv); w.y = pkbf(Og[db][2] * inv, Og[db][3] * inv);
        *(u32x2*)(orow + 16 * db + 4 * g) = w; }
}

template <int NI> __device__ __forceinline__ void ring_wait() { asm volatile("s_waitcnt vmcnt(%0)" :: "n"(2 * NI) : "memory"); __syncthreads(); }
__device__ __forceinline__ void drain_wait() { asm volatile("s_waitcnt vmcnt(0)" ::: "memory"); __syncthreads(); }
__device__ __forceinline__ int item_of(int it, int nmain, int ntotal) {
    const int bid = blockIdx.x, G = gridDim.x;
    if (G == 256 && nmain == 1024) { if (it < 4) return 128 * (bid & 7) + 32 * it + (bid >> 3); const int e = nmain + (it - 4) * 256 + bid; return e < ntotal ? e : -1; }
    const int e = bid + it * G; return e < ntotal ? e : -1;
}

constexpr int NA_BUF = 32768;
constexpr int NA_TAB = 4 * NA_BUF;
constexpr int NA_ITEMS_LAT = NB * 8 * 32, NA_ITEMS = NA_ITEMS_LAT + NB * 8;
__device__ __forceinline__ void na_phase(LAS unsigned char* lds, const bf16_t* Q, const bf16_t* K, const bf16_t* V, bf16_t* Ob, const float* rpb, float negb) {
    int tid_ = threadIdx.x; asm volatile("" : "+v"(tid_));
    const int tid = tid_, lane = tid & 63, w = __builtin_amdgcn_readfirstlane(tid >> 6), l15 = lane & 15, g = lane >> 4;
    LAS float* tab = (LAS float*)(lds + NA_TAB);
    for (int it = 0;; ++it) {
        const int item = item_of(it, NA_ITEMS_LAT, NA_ITEMS); if (item < 0) break;
        const bool isctx = item >= NA_ITEMS_LAT;
        int b, hp, rq;
        if (!isctx) { b = item >> 8; hp = (item >> 5) & 7; rq = item & 31; } else { const int j = item - NA_ITEMS_LAT; b = j >> 3; hp = j & 7; rq = 0; }
        const int hh = w >> 2, head = 2 * hp + hh;
        const size_t ctx0 = (size_t)(MLAT + b * NCTX), lat0 = (size_t)(b * SEQ);
        const int kr_lo = min(max(4 * rq - 4, 0), 120), kr_hi = min(max(4 * rq - 1, 0), 120) + 8;
        const int NT = 4 + (isctx ? 0 : kr_hi - kr_lo);
        const DmaLane dl = dma_lane(DM, hp * 128, w, lane);
#define NA_ROW0(t) ((t) < 4 ? ctx0 + 64 * (t) : ((t) < NT ? lat0 + (size_t)(kr_lo + (t) - 4) * 64 : ctx0))
        dma_tile<2>(lds, K, V, NA_ROW0(0), DM, dl, w);
        dma_tile<2>(lds + NA_BUF, K, V, NA_ROW0(1), DM, dl, w);
        dma_tile<2>(lds + 2 * NA_BUF, K, V, NA_ROW0(2), DM, dl, w);
        for (int i = tid; i < 2 * 465; i += 512) { const int h2 = i / 465, e = i - h2 * 465; tab[h2 * 512 + e] = rpb[(2 * hp + h2) * 465 + e] * LOG2E; }
        const int r = 4 * rq + (w & 3);
        const size_t qrow0 = isctx ? (size_t)(MLAT + b * NCTX + (w & 3) * 64) : (size_t)(b * SEQ + r * 64);
        bf16x8 qf[4][2];
#pragma unroll
        for (int grp = 0; grp < 4; ++grp)
#pragma unroll
            for (int ds = 0; ds < 2; ++ds) qf[grp][ds] = *(const bf16x8*)(Q + (qrow0 + 16 * grp + l15) * DM + head * 64 + 32 * ds + 8 * g);
        f32x4 O[4][4]; float ls[4];
#pragma unroll
        for (int grp = 0; grp < 4; ++grp) { ls[grp] = 0.f;
#pragma unroll
            for (int db = 0; db < 4; ++db) O[grp][db] = (f32x4){0.f, 0.f, 0.f, 0.f}; }
        const int r0w = min(max(r - 4, 0), 120);
        drain_wait();
        for (int t = 0; t < 4; ++t) {
            dma_tile<2>(lds + ((t + 3) & 3) * NA_BUF, K, V, NA_ROW0(t + 3), DM, dl, w);
            const LAS unsigned char* buf = lds + (t & 3) * NA_BUF;
            full_tile<0, 1, 2>(O, ls, qf, negb, buf + hh * 8192, buf + 2 * 8192 + hh * 8192, lane, 0);
            ring_wait<4>();
        }
        for (int t = 4; t < NT; ++t) {
            dma_tile<2>(lds + ((t + 3) & 3) * NA_BUF, K, V, NA_ROW0(t + 3), DM, dl, w);
            const LAS unsigned char* buf = lds + (t & 3) * NA_BUF;
            const int kr = kr_lo + t - 4; const bool rv = kr >= r0w && kr < r0w + 8;
            if (rv) na_local_tile(O, ls, qf, negb, buf + hh * 8192, buf + 2 * 8192 + hh * 8192, lane, tab + hh * 512 + (kr - r + 7) * 31, true);
            ring_wait<4>();
        }
#undef NA_ROW0
#pragma unroll
        for (int grp = 0; grp < 4; ++grp) { const float lt = red_sum4(ls[grp]); store_group(O[grp], __builtin_amdgcn_rcpf(lt), Ob + (qrow0 + 16 * grp + l15) * DM + head * 64, g); }
    }
}

constexpr int SW_BUF = 16384;
constexpr int SW_ITEMS = NB * 4 * 64;
__device__ __forceinline__ void swa_phase(LAS unsigned char* lds, const bf16_t* Q, const bf16_t* K, const bf16_t* V, bf16_t* Ob, const float* sink, float negb) {
    int tid_ = threadIdx.x; asm volatile("" : "+v"(tid_));
    const int tid = tid_, lane = tid & 63, w = __builtin_amdgcn_readfirstlane(tid >> 6), l15 = lane & 15, g = lane >> 4;
    for (int it = 0;; ++it) {
        const int item = item_of(it, SW_ITEMS, SW_ITEMS); if (item < 0) break;
        const int b = item >> 8, kvh = (item >> 6) & 3, tb = item & 63;
        const size_t ctx0 = (size_t)(MLAT + b * NCTX), lat0 = (size_t)(b * SEQ);
        const int i_lo = tb == 0 ? 2 : 0, i_hi = tb == 63 ? 4 : 6;
        const int NT = 4 + (i_hi - i_lo);
        const DmaLane dl = dma_lane(256, kvh * 64, w, lane);
#define SW_ROW0(t) ((t) < 4 ? ctx0 + 64 * (t) : ((t) < NT ? lat0 + (size_t)(128 * tb - 128 + 64 * (i_lo + (t) - 4)) : ctx0))
        dma_tile<1>(lds, K, V, SW_ROW0(0), 256, dl, w);
        dma_tile<1>(lds + SW_BUF, K, V, SW_ROW0(1), 256, dl, w);
        dma_tile<1>(lds + 2 * SW_BUF, K, V, SW_ROW0(2), 256, dl, w);
        const int tq = 128 * tb + 16 * w;
        const size_t qrow = (size_t)(b * SEQ + tq + l15);
        bf16x8 qf[4][2];
#pragma unroll
        for (int grp = 0; grp < 4; ++grp)
#pragma unroll
            for (int ds = 0; ds < 2; ++ds) qf[grp][ds] = *(const bf16x8*)(Q + qrow * DM + (4 * kvh + grp) * 64 + 32 * ds + 8 * g);
        f32x4 O[4][4]; float ls[4];
#pragma unroll
        for (int grp = 0; grp < 4; ++grp) { ls[grp] = 0.f;
#pragma unroll
            for (int db = 0; db < 4; ++db) O[grp][db] = (f32x4){0.f, 0.f, 0.f, 0.f}; }
        drain_wait();
        for (int t = 0; t < 4; ++t) {
            dma_tile<1>(lds + ((t + 3) & 3) * SW_BUF, K, V, SW_ROW0(t + 3), 256, dl, w);
            const LAS unsigned char* buf = lds + (t & 3) * SW_BUF;
            full_tile<0, 2, 2>(O, ls, qf, negb, buf, buf + 8192, lane, 0);
            ring_wait<2>();
        }
        for (int t = 4; t < NT; ++t) {
            dma_tile<1>(lds + ((t + 3) & 3) * SW_BUF, K, V, SW_ROW0(t + 3), 256, dl, w);
            const LAS unsigned char* buf = lds + (t & 3) * SW_BUF;
            const int start = 128 * tb - 128 + 64 * (i_lo + t - 4);
            if (start + 63 >= tq - 128 && start <= tq + 15 + 128)
                full_tile<1, 2, 2>(O, ls, qf, negb, buf, buf + 8192, lane, start - (tq + l15));
            ring_wait<2>();
        }
#undef SW_ROW0
#pragma unroll
        for (int grp = 0; grp < 4; ++grp) { const float lt = red_sum4(ls[grp]) + __builtin_amdgcn_exp2f(sink[4 * kvh + grp] * LOG2E + negb);
            store_group(O[grp], __builtin_amdgcn_rcpf(lt), Ob + qrow * DM + (4 * kvh + grp) * 64, g); }
    }
}
}

__device__ __forceinline__ float wave_sum(float v) {
#pragma unroll
    for (int o = 1; o < 64; o <<= 1) v += __shfl_xor(v, o);
    return v;
}
__device__ __forceinline__ void transpose_item(const float* W, int K, int N, bf16_t* WT, bool perm, LAS float* scr, int item, int lane) {
    const int nblk = N / 32, kb = item / nblk, nb = item % nblk, k0 = 64 * kb, n0 = 32 * nb;
    const int r0 = perm ? ((n0 & ~255) + 128 * ((n0 >> 5) & 1) + 32 * ((n0 >> 6) & 3)) : n0;
#pragma unroll
    for (int i = 0; i < 32; ++i) { const int kk = 2 * i + (lane >> 5); scr[kk * 33 + (lane & 31)] = W[(size_t)(k0 + kk) * N + n0 + (lane & 31)]; }
    asm volatile("s_waitcnt lgkmcnt(0)" ::: "memory");
    const int c = lane & 7;
#pragma unroll
    for (int j = 0; j < 4; ++j) { const int n = (lane >> 3) + 8 * j; const LAS float* s = scr + (8 * c) * 33 + n;
        u32x4 o; o.x = pkbf(s[0 * 33], s[1 * 33]); o.y = pkbf(s[2 * 33], s[3 * 33]); o.z = pkbf(s[4 * 33], s[5 * 33]); o.w = pkbf(s[6 * 33], s[7 * 33]);
        *(u32x4*)(WT + (size_t)(r0 + n) * K + k0 + 8 * c) = o; }
    asm volatile("s_waitcnt lgkmcnt(0)" ::: "memory");
}

struct Args {
    const float *x, *c, *ctx, *c_ctx, *ada_w, *ada_b, *g_mix, *g_mlp, *mlp_w1, *mlp_w2, *na_wqkv, *na_q_gain, *na_k_gain, *na_rpb, *na_wo,
                *swa_wqkv, *swa_q_gain, *swa_k_gain, *swa_sink, *swa_wo;
    float* out; unsigned char* ws;
};

__device__ __forceinline__ void prologue_phase(const Args& a, LAS unsigned char* lds) {
    const int tid = threadIdx.x, lane = tid & 63, w = __builtin_amdgcn_readfirstlane(tid >> 6);
    float* mods = (float*)(a.ws + WS_MODS);
    if (blockIdx.x < 96) {
        const int l = blockIdx.x / 48, cgp = blockIdx.x % 48; const int j = 128 * cgp + 2 * lane;
        LAS float* sil = (LAS float*)(lds + 32768);
        for (int i = tid; i < 5 * DM; i += 512) { const float cv = i < 4 * DM ? a.c[i] : a.c_ctx[i - 4 * DM]; sil[i] = cv / (1.0f + __expf(-cv)); }
        __syncthreads();
        float acc[5][2];
#pragma unroll
        for (int s = 0; s < 5; ++s) { acc[s][0] = 0.f; acc[s][1] = 0.f; }
        const float* wp = a.ada_w + ((size_t)l * DM + 128 * w) * 6144 + j;
#pragma unroll 8
        for (int kk = 0; kk < 128; ++kk) { const int k = 128 * w + kk; const f32x2_t wv = *(const f32x2_t*)(wp + (size_t)kk * 6144);
#pragma unroll
            for (int s = 0; s < 5; ++s) { const float sv = sil[s * DM + k]; acc[s][0] += sv * wv.x; acc[s][1] += sv * wv.y; } }
        LAS float* part = (LAS float*)lds;
#pragma unroll
        for (int s = 0; s < 5; ++s) { part[(w * 5 + s) * 128 + 2 * lane] = acc[s][0]; part[(w * 5 + s) * 128 + 2 * lane + 1] = acc[s][1]; }
        __syncthreads();
        for (int idx = tid; idx < 640; idx += 512) { const int s = idx >> 7, col = idx & 127; float t = 0.f;
#pragma unroll
            for (int ww = 0; ww < 8; ++ww) t += part[(ww * 5 + s) * 128 + col];
            mods[(l * 5 + s) * 6144 + 128 * cgp + col] = t + a.ada_b[l * 6144 + 128 * cgp + col]; }
        __syncthreads();
    } else if (blockIdx.x == 96) {
        float* rope = (float*)(a.ws + WS_ROPE);
        for (int idx = tid; idx < 2048; idx += 512) { const int pos = idx >> 4, f = idx & 15;
            const float inv = exp2f(-(float)f * (13.287712379549449f / 16.0f)); const float ang = (float)pos * inv;
            float xr = ang * 0.15915494309189535f; xr -= floorf(xr);
            rope[idx] = __builtin_amdgcn_cosf(xr); rope[2048 + idx] = __builtin_amdgcn_sinf(xr); }
        float* gains = (float*)(a.ws + WS_GAINS);
        if (tid < 256) { const int l = tid >> 7, k = (tid >> 6) & 1, d = tid & 63;
            const float* src = l == 0 ? (k == 0 ? a.na_q_gain : a.na_k_gain) : (k == 0 ? a.swa_q_gain : a.swa_k_gain);
            gains[tid] = src[d] * (k == 0 ? QSCALE : 1.0f); }
        if (tid == 0) *(Args*)(a.ws + WS_ARGS) = a;
        float mxb = -1e30f;
        for (int i = tid; i < NHEAD * 465; i += 512) mxb = fmaxf(mxb, a.na_rpb[i]);
#pragma unroll
        for (int o = 1; o < 64; o <<= 1) mxb = fmaxf(mxb, __shfl_xor(mxb, o));
        LAS float* red = (LAS float*)lds;
        if (lane == 0) red[w] = mxb;
        __syncthreads();
        if (w == 0) {
            float g0 = fabsf(a.na_q_gain[lane]), g1 = fabsf(a.na_k_gain[lane]), g2 = fabsf(a.swa_q_gain[lane]), g3 = fabsf(a.swa_k_gain[lane]);
#pragma unroll
            for (int o = 1; o < 64; o <<= 1) { g0 = fmaxf(g0, __shfl_xor(g0, o)); g1 = fmaxf(g1, __shfl_xor(g1, o)); g2 = fmaxf(g2, __shfl_xor(g2, o)); g3 = fmaxf(g3, __shfl_xor(g3, o)); }
            float mb = red[0];
#pragma unroll
            for (int i = 1; i < 8; ++i) mb = fmaxf(mb, red[i]);
            if (lane == 0) { float* bnd = (float*)(a.ws + WS_BND); bnd[0] = (8.0f * g0 * g1 + fmaxf(mb, 0.f)) * LOG2E; bnd[1] = 8.0f * g2 * g3 * LOG2E; }
        }
        __syncthreads();
    }
    LAS float* scr = (LAS float*)(lds + w * 16384);
    const int gw = blockIdx.x * 8 + w, ngw = gridDim.x * 8;
    constexpr int I_QKV0 = 16 * 96, I_WO = 16 * 32, I_QKV1 = 16 * 48, I_W1 = 16 * 128, I_W2 = 64 * 32;
    constexpr int NITEMS = I_QKV0 + 2 * I_WO + I_QKV1 + 2 * I_W1 + 2 * I_W2;
    constexpr int HCAP = 2; const int nfree = ((int)gridDim.x > 96 ? (int)gridDim.x - 96 : 0) * 8, pre = nfree * HCAP < NITEMS ? nfree * HCAP : 0;
    const int fw = ((int)blockIdx.x - 96) * 8 + w;
    for (int k = 0;; ++k) {
        int it;
        if (pre && k < HCAP) { if ((int)blockIdx.x < 96) continue; it = fw + k * nfree; }
        else { it = pre + gw + (k - (pre ? HCAP : 0)) * ngw; if (it >= NITEMS) break; }
        int r = it;
        if (r < I_QKV0) { transpose_item(a.na_wqkv, DM, 3072, (bf16_t*)(a.ws + WS_WQKV0), true, scr, r, lane); continue; } r -= I_QKV0;
        if (r < I_WO) { transpose_item(a.na_wo, DM, DM, (bf16_t*)(a.ws + WS_WO0), false, scr, r, lane); continue; } r -= I_WO;
        if (r < I_QKV1) { transpose_item(a.swa_wqkv, DM, 1536, (bf16_t*)(a.ws + WS_WQKV1), true, scr, r, lane); continue; } r -= I_QKV1;
        if (r < I_WO) { transpose_item(a.swa_wo, DM, DM, (bf16_t*)(a.ws + WS_WO1), false, scr, r, lane); continue; } r -= I_WO;
        if (r < 2 * I_W1) { const int l = r / I_W1; transpose_item(a.mlp_w1 + (size_t)l * DM * DFF, DM, DFF, (bf16_t*)(a.ws + WS_W1) + (size_t)l * DM * DFF, false, scr, r % I_W1, lane); continue; } r -= 2 * I_W1;
        { const int l = r / I_W2; transpose_item(a.mlp_w2 + (size_t)l * DM * DFF, DFF, DM, (bf16_t*)(a.ws + WS_W2) + (size_t)l * DM * DFF, false, scr, r % I_W2, lane); }
    }
}

__device__ __forceinline__ void norm_phase(const void* src_lat, int lat_f32, const float* src_ctx, int nrows, const float* gvec, const float* mods_l, int sh_off, int sc_off, bf16_t* U, const float* part, int nparts, float* ctx_out) {
    int tid_ = threadIdx.x; asm volatile("" : "+v"(tid_));
    const int lane = tid_ & 63, w = __builtin_amdgcn_readfirstlane(tid_ >> 6);
    const int gw = blockIdx.x * 8 + w, ngw = gridDim.x * 8;

    f32x4 gv[4];
#pragma unroll
    for (int j = 0; j < 4; ++j) gv[j] = *(const f32x4*)(gvec + 4 * lane + 256 * j);
    for (int row = gw; row < nrows; row += ngw) {
        const int s = row < MLAT ? (row >> 13) : 4;
        f32x4 v[4]; float ss = 0.f;
        if (row < MLAT && !lat_f32) { const bf16_t* src = (const bf16_t*)src_lat + (size_t)row * DM + 4 * lane;
#pragma unroll
            for (int j = 0; j < 4; ++j) { const u32x2 w = *(const u32x2*)(src + 256 * j);
                v[j] = (f32x4){__uint_as_float(w.x << 16), __uint_as_float(w.x & 0xffff0000u), __uint_as_float(w.y << 16), __uint_as_float(w.y & 0xffff0000u)}; } }
        else { const float* src = row < MLAT ? (const float*)src_lat + (size_t)row * DM : src_ctx + (size_t)(row - MLAT) * DM;
#pragma unroll
            for (int j = 0; j < 4; ++j) v[j] = *(const f32x4*)(src + 4 * lane + 256 * j); }
#pragma unroll
        for (int j = 0; j < 4; ++j) { ss += (v[j][0] * v[j][0] + v[j][1] * v[j][1]) + (v[j][2] * v[j][2] + v[j][3] * v[j][3]); }
        if (nparts != 0 && row >= MLAT) {
            for (int ch = 0; ch < nparts; ch += 4) {
                f32x4 pv[4][4];
#pragma unroll
                for (int c4 = 0; c4 < 4; ++c4) { const float* pr = part + ((size_t)(ch + c4) * MCTX + (row - MLAT)) * DM + 4 * lane;
#pragma unroll
                    for (int j = 0; j < 4; ++j) pv[c4][j] = *(const f32x4*)(pr + 256 * j); }
#pragma unroll
                for (int c4 = 0; c4 < 4; ++c4)
#pragma unroll
                    for (int j = 0; j < 4; ++j) v[j] = v[j] + pv[c4][j]; }
            ss = 0.f;
#pragma unroll
            for (int j = 0; j < 4; ++j) { *(f32x4*)(ctx_out + (size_t)(row - MLAT) * DM + 4 * lane + 256 * j) = v[j]; ss += (v[j][0] * v[j][0] + v[j][1] * v[j][1]) + (v[j][2] * v[j][2] + v[j][3] * v[j][3]); }
        }
        const float rs = rsqrtf(wave_sum64(ss) * (1.0f / DM) + EPS);
        const float* shp = mods_l + s * 6144 + sh_off + 4 * lane; const float* scp = mods_l + s * 6144 + sc_off + 4 * lane;
        bf16_t* up = U + (size_t)row * DM + 4 * lane;
#pragma unroll
        for (int j = 0; j < 4; ++j) { const f32x4 sh = *(const f32x4*)(shp + 256 * j), sc = *(const f32x4*)(scp + 256 * j);
            const f32x4 y = v[j] * rs * gv[j] * (sc + 1.0f) + sh;
            u32x2 o; o.x = pkbf(y[0], y[1]); o.y = pkbf(y[2], y[3]); *(u32x2*)(up + 256 * j) = o; }
    }
}

#define XB_TMO      128
#define XB_XCNT(j)  (256  + 64 * (j))
#define XB_XSUB(j)  (1280 + 64 * (j))
#define XB_XGEN(j)  (2304 + 64 * (j))
#define XB_TOP      3328
#define XB_TOPGEN   3392
#define XCD_BAR_WORDS 3456
#define XB_SPIN_CAP (1u << 18)

__device__ __forceinline__ unsigned xb_ld(unsigned* p)              { return __hip_atomic_load(p, __ATOMIC_RELAXED, __HIP_MEMORY_SCOPE_AGENT); }
__device__ __forceinline__ unsigned xb_add(unsigned* p, unsigned v) { return __hip_atomic_fetch_add(p, v, __ATOMIC_RELAXED, __HIP_MEMORY_SCOPE_AGENT); }
__device__ __forceinline__ unsigned xb_xcc_id() { return (unsigned)__builtin_amdgcn_s_getreg((3 << 11) | 20) & 0xFu; }
#define XB_SPIN(cond, bar) do { unsigned _sp = 0; while (cond) { __builtin_amdgcn_s_sleep(1); \
    if ((++_sp & 255u) == 0u) { if (xb_ld(&(bar)[XB_TMO])) break; if (_sp > XB_SPIN_CAP) { atomicAdd(&(bar)[XB_TMO], 1u); break; } } } } while (0)

struct XcdBarrier {
    unsigned* bar; unsigned x;
    volatile LAS unsigned* st;
};

__device__ __forceinline__ XcdBarrier xcd_barrier_post(unsigned* bar, volatile LAS unsigned* st) {
    XcdBarrier b; b.bar = bar; b.x = xb_xcc_id(); b.st = st;
    if (threadIdx.x == 0) (void)xb_add(&bar[XB_XCNT(b.x)], 1u);
    return b;
}
__device__ __forceinline__ void xcd_barrier_complete(unsigned* bar, unsigned x, unsigned& nloc, unsigned& nx) {
    const unsigned G = gridDim.x * gridDim.y * gridDim.z;
    unsigned sum, cnt, mine, sp = 0u;
    for (;;) {
        sum = 0u; cnt = 0u; mine = 0u;
#pragma unroll
        for (unsigned j = 0; j < 16; ++j) { const unsigned c = xb_ld(&bar[XB_XCNT(j)]); sum += c; cnt += (c > 0u) ? 1u : 0u; mine = (j == x) ? c : mine; }
        if (sum == G) break;
        __builtin_amdgcn_s_sleep(1);
        if ((++sp & 255u) == 0u) { if (xb_ld(&bar[XB_TMO])) break; if (sp > XB_SPIN_CAP) { atomicAdd(&bar[XB_TMO], 1u); break; } }
    }
    nloc = mine > 0u ? mine : 1u; nx = cnt > 0u ? cnt : 1u;
}

__device__ __forceinline__ void xcd_barrier(const XcdBarrier& b) {
    asm volatile("s_waitcnt vmcnt(0)" ::: "memory");
    __syncthreads();
    if (threadIdx.x == 0) {
        unsigned* bar = b.bar;
        __builtin_amdgcn_s_waitcnt(0);
        unsigned nloc = b.st[0], nx = b.st[1];
        if (nloc == 0u) { xcd_barrier_complete(bar, b.x, nloc, nx); b.st[0] = nloc; b.st[1] = nx; }
        const unsigned old = xb_add(&bar[XB_XSUB(b.x)], 1u);
        const unsigned gen = old / nloc;
        if (old + 1u == (gen + 1u) * nloc) {
            __builtin_amdgcn_fence(__ATOMIC_RELEASE, "agent");
            asm volatile("s_waitcnt vmcnt(0)" ::: "memory");
            const unsigned og = xb_add(&bar[XB_TOP], 1u);
            const unsigned tg = og / nx;
            if (og + 1u == (tg + 1u) * nx) xb_add(&bar[XB_TOPGEN], 1u);
            else XB_SPIN(xb_ld(&bar[XB_TOPGEN]) == tg, bar);
            __builtin_amdgcn_fence(__ATOMIC_ACQUIRE, "agent");
            xb_add(&bar[XB_XGEN(b.x)], 1u);
            asm volatile("s_waitcnt vmcnt(0)" ::: "memory");
        } else {
            XB_SPIN(xb_ld(&bar[XB_XGEN(b.x)]) == gen, bar);
            __builtin_amdgcn_fence(__ATOMIC_ACQUIRE, "agent");
            asm volatile("s_waitcnt vmcnt(0)" ::: "memory");
        }
    }
    __syncthreads();
}

constexpr int LDS_BYTES = 147456;
static_assert(att::NA_TAB + 2 * 512 * 4 <= LDS_BYTES, "LDS map");

__global__ void __launch_bounds__(512, 2) fwd_megakernel(Args a) {
    extern __shared__ __attribute__((aligned(16))) unsigned char lds_raw[];
    LAS unsigned char* lds = (LAS unsigned char*)lds_raw;
#define GSYNC() cg::this_grid().sync()
    unsigned char* const ws = a.ws;
    volatile LAS unsigned* xst = (volatile LAS unsigned*)(lds + LDS_BYTES - 16);
    if (threadIdx.x < 4) xst[threadIdx.x] = 0u;
    __syncthreads();
    XcdBarrier xb0 = xcd_barrier_post((unsigned*)(ws + WS_BAR), xst); (void)xb0;
    if ((const void*)a.c == (const void*)a.ws) GSYNC();
    prologue_phase(a, lds);
#define XSYNC() do { XcdBarrier xb_; xb_.bar = (unsigned*)(ws + WS_BAR); xb_.x = xb_xcc_id(); xb_.st = (volatile LAS unsigned*)(lds + LDS_BYTES - 16); xcd_barrier(xb_); } while (0)
    XSYNC();
    const Args* A = (const Args*)(ws + WS_ARGS);
#define WSP(T, off) ((T*)(ws + (off)))
#pragma unroll 1
    for (int l = 0; l < 2; ++l) {
        const int M = l == 0 ? MALL : MLAT;
#ifndef NORM_REP
#define NORM_REP 1
#endif
#pragma unroll 1
        for (int rep = 0; rep < NORM_REP; ++rep) {
        norm_phase(l == 0 ? (const void*)A->x : (const void*)WSP(bf16_t, WS_HB), l == 0, l == 0 ? A->ctx : WSP(float, WS_HC), MALL, A->g_mix + l * DM, WSP(float, WS_MODS) + l * 5 * 6144, 0, 1024, WSP(bf16_t, WS_U), WSP(const float, WS_PART), l == 0 ? 0 : 16, WSP(float, WS_HC));
        XSYNC();
        }
        {
            const int N = l == 0 ? 3072 : 1536;
            pg8::Gemm g{WSP(bf16_t, WS_U), WSP(const bf16_t, l == 0 ? WS_WQKV0 : WS_WQKV1), MALL, N, DM, 2}; pg8::StaticOrder S; S.init(MALL, N, gridDim.x, blockIdx.x);
            EpiQKV E{WSP(bf16_t, WS_Q), (size_t)(WS_K - WS_Q) / 2, l == 0 ? DM : 256, l == 0 ? 4 : 1, WSP(float, WS_GAINS) + l * 128, l == 0 ? nullptr : WSP(const float, WS_ROPE)};
            pg8::gemm_phase<EpiQKV, pg8::StaticOrder, true, true>(lds, g, S, E);
        }
        XSYNC();
#ifndef ATT_REP
#define ATT_REP 1
#endif
#pragma unroll 1
        for (int rep = 0; rep < ATT_REP; ++rep) {
        if (l == 0) att::na_phase(lds, WSP(bf16_t, WS_Q), WSP(bf16_t, WS_K), WSP(bf16_t, WS_V), WSP(bf16_t, WS_O), A->na_rpb, -WSP(const float, WS_BND)[0]);
        else att::swa_phase(lds, WSP(bf16_t, WS_Q), WSP(bf16_t, WS_K), WSP(bf16_t, WS_V), WSP(bf16_t, WS_O), A->swa_sink, -WSP(const float, WS_BND)[1]);
        XSYNC();
        }
        {
            pg8::Gemm g{WSP(bf16_t, WS_O), WSP(const bf16_t, l == 0 ? WS_WO0 : WS_WO1), M, DM, DM, 2}; SplitOrder S; S.init(DM, DM, l == 0 ? 4 : 0, gridDim.x, blockIdx.x);
            EpiRes E{l == 0 ? (const void*)A->x : (const void*)WSP(bf16_t, WS_HB), WSP(float, WS_HC), WSP(bf16_t, WS_HB), WSP(float, WS_HC), WSP(float, WS_MODS) + l * 5 * 6144 + 2048, WSP(float, WS_PART), l == 0, 0};
            pg8::gemm_phase<EpiRes, SplitOrder, true, true>(lds, g, S, E);
        }
        XSYNC();
#pragma unroll 1
        for (int rep = 0; rep < NORM_REP; ++rep) {
        norm_phase(WSP(bf16_t, WS_HB), 0, l == 0 ? A->ctx : WSP(float, WS_HC), M, A->g_mlp + l * DM, WSP(float, WS_MODS) + l * 5 * 6144, 3072, 4096, WSP(bf16_t, WS_U), WSP(const float, WS_PART), l == 0 ? 4 : 0, WSP(float, WS_HC));
        XSYNC();
        }
#ifndef UP_REP
#define UP_REP 1
#endif
#pragma unroll 1
        for (int rep = 0; rep < UP_REP; ++rep) {
        if (rep) XSYNC();
        {
            pg8::Gemm g{WSP(bf16_t, WS_U), WSP(const bf16_t, WS_W1) + (size_t)l * DM * DFF, M, DFF, DM, 2}; pg8::StaticOrder S; S.init(M, DFF, gridDim.x, blockIdx.x);
            EpiRelu2 E{WSP(bf16_t, WS_HMID), DFF};
            pg8::gemm_phase<EpiRelu2, pg8::StaticOrder, true, true>(lds, g, S, E);
        }
        }
        XSYNC();
        {
            pg8::Gemm g{WSP(bf16_t, WS_HMID), WSP(const bf16_t, WS_W2) + (size_t)l * DM * DFF, M, DM, DFF, 1}; SplitOrder S; S.init(DM, DFF, l == 0 ? 16 : 0, gridDim.x, blockIdx.x, true);
            EpiRes E{WSP(bf16_t, WS_HB), WSP(float, WS_HC), l == 0 ? (void*)WSP(bf16_t, WS_HB) : (void*)A->out, WSP(float, WS_HC), WSP(float, WS_MODS) + l * 5 * 6144 + 5120, WSP(float, WS_PART), 0, l == 1};
            pg8::gemm_phase<EpiRes, SplitOrder, true, true>(lds, g, S, E);
        }
        if (l == 0) XSYNC();
    }
#undef WSP
}

extern "C" void kernel_launch(void* const* d_in, const int* in_sizes, int n_in, void* d_out, int out_size, void* d_ws, size_t ws_size, hipStream_t stream) {
    static int grid_blocks = 0;
    if (grid_blocks == 0) {
        if (n_in != 20 || out_size != MLAT * DM || ws_size < WS_END) { fprintf(stderr, "kernel_launch: unexpected shapes (n_in %d out %d ws %zu)\n", n_in, out_size, ws_size); grid_blocks = -1; return; }
        int dev = 0, cus = 0, per_cu = 0;
        hipGetDevice(&dev);
        hipDeviceGetAttribute(&cus, hipDeviceAttributeMultiprocessorCount, dev);
        hipFuncSetAttribute((const void*)fwd_megakernel, hipFuncAttributeMaxDynamicSharedMemorySize, LDS_BYTES);
        hipOccupancyMaxActiveBlocksPerMultiprocessor(&per_cu, (const void*)fwd_megakernel, 512, LDS_BYTES);
        if (per_cu < 1) { fprintf(stderr, "kernel_launch: occupancy query says %d blocks per CU\n", per_cu); per_cu = 1; }
        grid_blocks = cus * per_cu;
    }
    if (grid_blocks < 0) return;
    if (hipMemsetAsync((unsigned char*)d_ws + WS_BAR, 0, XCD_BAR_WORDS * 4, stream) != hipSuccess) { fprintf(stderr, "kernel_launch: hipMemsetAsync of the barrier words failed\n"); return; }
    Args a{};
    const float** ap = (const float**)&a;
    for (int i = 0; i < 20; ++i) ap[i] = (const float*)d_in[i];
    a.out = (float*)d_out; a.ws = (unsigned char*)d_ws;
    void* args[] = {&a};
    hipError_t e = hipLaunchCooperativeKernel((const void*)fwd_megakernel, dim3(grid_blocks), dim3(512), args, LDS_BYTES, stream);
    if (e != hipSuccess) fprintf(stderr, "cooperative launch failed: %s (grid %d)\n", hipGetErrorString(e), grid_blocks);
}
```
